# Optimizing an MI355X kernel written in HIP

```python
import jax, jax.numpy as jnp
from jax import lax
import numpy as np

D_MODEL = 2048
BATCH = 8
SEQ = 4096
DEPTH = 2
DEC_BATCH = 8
DEC_SEQ = 16
PAST_LEN = 2048

CHUNK = 64
N_MIXERS = 2
N_FOX_LAYERS = (DEPTH + 1) // 2
N_LRU_LAYERS = DEPTH // 2
FOX_HEADS = 16
FOX_HEAD_DIM = D_MODEL // FOX_HEADS
Q_BLOCK = 128
FORGET_BIAS = 3.0
LRU_WIDTH = D_MODEL
LRU_BLOCKS = 8
LRU_BLOCK_W = LRU_WIDTH // LRU_BLOCKS
CONV_W = 4
LRU_C = 8.0
N_MEM = 256
MEM_HEADS = 4
MEM_HEAD_DIM = 128
MEM_WIDTH = MEM_HEADS * MEM_HEAD_DIM
D_FF = -(-8 * D_MODEL // (3 * 256)) * 256
EPS = 1e-6

kernel_name = 'fox_rglru_hybrid_stream_step'


def rmsnorm(x, g):
    xf = x.astype(jnp.float32)
    y = xf * lax.rsqrt(jnp.mean(xf * xf, axis=-1, keepdims=True) + EPS) * g.astype(jnp.float32)
    return y.astype(x.dtype)


def fox_project(h, w_in, b_f):
    B, T, _ = h.shape
    proj = h @ w_in
    q = proj[..., :D_MODEL].reshape(B, T, FOX_HEADS, FOX_HEAD_DIM)
    k = proj[..., D_MODEL:2 * D_MODEL].reshape(B, T, FOX_HEADS, FOX_HEAD_DIM)
    v = proj[..., 2 * D_MODEL:3 * D_MODEL].reshape(B, T, FOX_HEADS, FOX_HEAD_DIM)
    logf = jax.nn.log_sigmoid(proj[..., 3 * D_MODEL:].astype(jnp.float32) + b_f.astype(jnp.float32))
    return q, k, v, logf


def fox_attend(q, cq, qpos, k, v, ck, kpos):
    s = jnp.einsum('bqhd,bkhd->bhqk', q, k).astype(jnp.float32) * (FOX_HEAD_DIM ** -0.5)
    bias = jnp.swapaxes(cq, 1, 2)[:, :, :, None] - jnp.swapaxes(ck, 1, 2)[:, :, None, :]
    mask = kpos[None, :] <= qpos[:, None]
    p = jax.nn.softmax(jnp.where(mask, s + bias, -jnp.inf), axis=-1)
    return jnp.einsum('bhqk,bkhd->bqhd', p.astype(v.dtype), v)


def fox_prompt_attend(q, k, v, logf):
    B, S = q.shape[:2]
    c = jnp.cumsum(logf, axis=1)
    kpos = jnp.arange(S)

    def block(start):
        qb = lax.dynamic_slice_in_dim(q, start, Q_BLOCK, axis=1)
        cb = lax.dynamic_slice_in_dim(c, start, Q_BLOCK, axis=1)
        return fox_attend(qb, cb, start + jnp.arange(Q_BLOCK), k, v, c, kpos)

    out = lax.map(block, jnp.arange(S // Q_BLOCK) * Q_BLOCK)
    return jnp.moveaxis(out, 0, 1).reshape(B, S, D_MODEL)


def fox_sample_attend(q, k, v, logf, cache_k, cache_v, cache_logf):
    B, T = q.shape[:2]
    P = cache_k.shape[1]
    k_all = jnp.concatenate([cache_k.astype(k.dtype), k], axis=1)
    v_all = jnp.concatenate([cache_v.astype(v.dtype), v], axis=1)
    c = jnp.cumsum(jnp.concatenate([cache_logf.astype(jnp.float32), logf], axis=1), axis=1)
    out = fox_attend(q, c[:, P:], P + jnp.arange(T), k_all, v_all, c, jnp.arange(P + T))
    return out.reshape(B, T, D_MODEL)


def rglru_block(h, w_in, conv_w, conv_b, w_ga, b_a, w_gx, b_x, lam, w_out, h0, conv_buf):
    B, T, _ = h.shape
    proj = h @ w_in
    gate = jax.nn.gelu(proj[..., :LRU_WIDTH])
    u = proj[..., LRU_WIDTH:]
    padded = jnp.concatenate([conv_buf.astype(u.dtype), u], axis=1)
    uc = conv_b + sum(padded[:, k:k + T] * conv_w[k] for k in range(CONV_W))
    new_buf = padded[:, padded.shape[1] - (CONV_W - 1):]
    ub = uc.reshape(B, T, LRU_BLOCKS, LRU_BLOCK_W)
    r = jax.nn.sigmoid((jnp.einsum('btnc,ncd->btnd', ub, w_ga).reshape(B, T, LRU_WIDTH) + b_a).astype(jnp.float32))
    ig = jax.nn.sigmoid((jnp.einsum('btnc,ncd->btnd', ub, w_gx).reshape(B, T, LRU_WIDTH) + b_x).astype(jnp.float32))
    log_a = -LRU_C * jax.nn.softplus(-lam.astype(jnp.float32)) * r
    a = jnp.exp(log_a)
    b = jnp.sqrt(-jnp.expm1(2.0 * log_a)) * (ig * uc.astype(jnp.float32))

    def step(hc, inp):
        a_t, b_t = inp
        hc = a_t * hc + b_t
        return hc, hc

    h_last, hs = lax.scan(step, h0.astype(jnp.float32), (jnp.swapaxes(a, 0, 1), jnp.swapaxes(b, 0, 1)))
    y = jnp.swapaxes(hs, 0, 1).astype(h.dtype) * gate
    return y @ w_out, h_last, new_buf


def mem_kv(mem, g, w_kv):
    B, N, _ = mem.shape
    kv = rmsnorm(mem, g) @ w_kv
    k = kv[..., :MEM_WIDTH].reshape(B, N, MEM_HEADS, MEM_HEAD_DIM)
    v = kv[..., MEM_WIDTH:].reshape(B, N, MEM_HEADS, MEM_HEAD_DIM)
    return k, v


def mem_xattn(h, w_q, mk, mv, w_o):
    B, T, _ = h.shape
    q = (h @ w_q).reshape(B, T, MEM_HEADS, MEM_HEAD_DIM)
    s = jnp.einsum('bqhd,bmhd->bhqm', q, mk.astype(q.dtype)).astype(jnp.float32) * (MEM_HEAD_DIM ** -0.5)
    p = jax.nn.softmax(s, axis=-1)
    o = jnp.einsum('bhqm,bmhd->bqhd', p.astype(h.dtype), mv.astype(h.dtype))
    return o.reshape(B, T, MEM_WIDTH) @ w_o


def swiglu(h, w_in, w_out):
    gu = h @ w_in
    return (jax.nn.silu(gu[..., :D_FF]) * gu[..., D_FF:]) @ w_out


def setup_inputs(seed: int = 0) -> dict:
    key = jax.random.key(seed)
    ks = iter(jax.random.split(key, 40))
    f32 = jnp.float32

    def nrm(shape, scale):
        return jax.random.normal(next(ks), shape, f32) * scale

    def gain(shape):
        return 1.0 + 0.05 * jax.random.normal(next(ks), shape, f32)

    a0 = jax.random.uniform(next(ks), (N_LRU_LAYERS, LRU_WIDTH), f32, 0.9, 0.999)
    d = {
        'x_prompt': nrm((BATCH, SEQ, D_MODEL), 1.0),
        'x_sample': nrm((DEC_BATCH, DEC_SEQ, D_MODEL), 1.0),
        'mem_prompt': nrm((BATCH, N_MEM, D_MODEL), 1.0),
        'cache_fox_k': nrm((N_FOX_LAYERS, DEC_BATCH, PAST_LEN, FOX_HEADS, FOX_HEAD_DIM), 1.0),
        'cache_fox_v': nrm((N_FOX_LAYERS, DEC_BATCH, PAST_LEN, FOX_HEADS, FOX_HEAD_DIM), 1.0),
        'cache_fox_logf': jax.nn.log_sigmoid(FORGET_BIAS + nrm((N_FOX_LAYERS, DEC_BATCH, PAST_LEN, FOX_HEADS), 0.5)),
        'cache_mem_k': nrm((DEPTH, DEC_BATCH, N_MEM, MEM_HEADS, MEM_HEAD_DIM), 1.0),
        'cache_mem_v': nrm((DEPTH, DEC_BATCH, N_MEM, MEM_HEADS, MEM_HEAD_DIM), 1.0),
        'state_lru_h': nrm((N_LRU_LAYERS, DEC_BATCH, LRU_WIDTH), 0.5),
        'state_lru_conv': nrm((N_LRU_LAYERS, DEC_BATCH, CONV_W - 1, LRU_WIDTH), 1.0),
        'norm_mix': gain((DEPTH, D_MODEL)),
        'norm_mem': gain((DEPTH, D_MODEL)),
        'norm_xattn': gain((DEPTH, D_MODEL)),
        'norm_ffn': gain((DEPTH, D_MODEL)),
        'norm_final': gain((D_MODEL,)),
        'fox_w_in': nrm((N_FOX_LAYERS, D_MODEL, 3 * D_MODEL + FOX_HEADS), D_MODEL ** -0.5),
        'fox_b_f': FORGET_BIAS + nrm((N_FOX_LAYERS, FOX_HEADS), 0.1),
        'fox_w_out': nrm((N_FOX_LAYERS, D_MODEL, D_MODEL), D_MODEL ** -0.5),
        'lru_w_in': nrm((N_LRU_LAYERS, D_MODEL, 2 * LRU_WIDTH), D_MODEL ** -0.5),
        'lru_conv_w': nrm((N_LRU_LAYERS, CONV_W, LRU_WIDTH), CONV_W ** -0.5),
        'lru_conv_b': nrm((N_LRU_LAYERS, LRU_WIDTH), 0.01),
        'lru_w_ga': nrm((N_LRU_LAYERS, LRU_BLOCKS, LRU_BLOCK_W, LRU_BLOCK_W), LRU_BLOCK_W ** -0.5),
        'lru_b_a': nrm((N_LRU_LAYERS, LRU_WIDTH), 0.01),
        'lru_w_gx': nrm((N_LRU_LAYERS, LRU_BLOCKS, LRU_BLOCK_W, LRU_BLOCK_W), LRU_BLOCK_W ** -0.5),
        'lru_b_x': nrm((N_LRU_LAYERS, LRU_WIDTH), 0.01),
        'lru_lambda': jnp.log(a0) - jnp.log1p(-a0),
        'lru_w_out': nrm((N_LRU_LAYERS, LRU_WIDTH, D_MODEL), LRU_WIDTH ** -0.5),
        'xattn_w_q': nrm((DEPTH, D_MODEL, MEM_WIDTH), D_MODEL ** -0.5),
        'xattn_w_kv': nrm((DEPTH, D_MODEL, 2 * MEM_WIDTH), D_MODEL ** -0.5),
        'xattn_w_o': nrm((DEPTH, MEM_WIDTH, D_MODEL), MEM_WIDTH ** -0.5),
        'ffn_w_in': nrm((DEPTH, D_MODEL, 2 * D_FF), D_MODEL ** -0.5),
        'ffn_w_out': nrm((DEPTH, D_FF, D_MODEL), D_FF ** -0.5),
    }
    return d


def reference(x_prompt, x_sample, mem_prompt, cache_fox_k, cache_fox_v, cache_fox_logf,
              cache_mem_k, cache_mem_v, state_lru_h, state_lru_conv,
              norm_mix, norm_mem, norm_xattn, norm_ffn, norm_final,
              fox_w_in, fox_b_f, fox_w_out,
              lru_w_in, lru_conv_w, lru_conv_b, lru_w_ga, lru_b_a, lru_w_gx, lru_b_x, lru_lambda, lru_w_out,
              xattn_w_q, xattn_w_kv, xattn_w_o, ffn_w_in, ffn_w_out):
    xp, xs = x_prompt, x_sample
    pk, pv, plf, pmk, pmv, ph, pc = [], [], [], [], [], [], []
    sk, sv, slf, sh, sc = [], [], [], [], []
    for i in range(DEPTH):
        j = i // N_MIXERS
        hp = rmsnorm(xp, norm_mix[i])
        hs = rmsnorm(xs, norm_mix[i])
        if i % N_MIXERS == 0:
            qp, kp, vp, lfp = fox_project(hp, fox_w_in[j], fox_b_f[j])
            xp = xp + fox_prompt_attend(qp, kp, vp, lfp) @ fox_w_out[j]
            qs, ks_, vs, lfs = fox_project(hs, fox_w_in[j], fox_b_f[j])
            xs = xs + fox_sample_attend(qs, ks_, vs, lfs, cache_fox_k[j], cache_fox_v[j], cache_fox_logf[j]) @ fox_w_out[j]
            pk.append(kp); pv.append(vp); plf.append(lfp)
            sk.append(ks_); sv.append(vs); slf.append(lfs)
        else:
            h0 = jnp.zeros((xp.shape[0], LRU_WIDTH), xp.dtype)
            buf0 = jnp.zeros((xp.shape[0], CONV_W - 1, LRU_WIDTH), xp.dtype)
            op, hlp, bp = rglru_block(hp, lru_w_in[j], lru_conv_w[j], lru_conv_b[j], lru_w_ga[j], lru_b_a[j],
                                      lru_w_gx[j], lru_b_x[j], lru_lambda[j], lru_w_out[j], h0, buf0)
            os_, hls, bs = rglru_block(hs, lru_w_in[j], lru_conv_w[j], lru_conv_b[j], lru_w_ga[j], lru_b_a[j],
                                       lru_w_gx[j], lru_b_x[j], lru_lambda[j], lru_w_out[j], state_lru_h[j], state_lru_conv[j])
            xp = xp + op
            xs = xs + os_
            ph.append(hlp); pc.append(bp); sh.append(hls); sc.append(bs)
        mk, mv = mem_kv(mem_prompt, norm_mem[i], xattn_w_kv[i])
        pmk.append(mk); pmv.append(mv)
        xp = xp + mem_xattn(rmsnorm(xp, norm_xattn[i]), xattn_w_q[i], mk, mv, xattn_w_o[i])
        xs = xs + mem_xattn(rmsnorm(xs, norm_xattn[i]), xattn_w_q[i], cache_mem_k[i], cache_mem_v[i], xattn_w_o[i])
        xp = xp + swiglu(rmsnorm(xp, norm_ffn[i]), ffn_w_in[i], ffn_w_out[i])
        xs = xs + swiglu(rmsnorm(xs, norm_ffn[i]), ffn_w_in[i], ffn_w_out[i])
    y_prompt = rmsnorm(xp, norm_final)
    y_sample = rmsnorm(xs, norm_final)
    return (y_prompt, y_sample,
            jnp.stack(pk), jnp.stack(pv), jnp.stack(plf), jnp.stack(pmk), jnp.stack(pmv),
            jnp.stack(ph), jnp.stack(pc),
            jnp.stack(sk), jnp.stack(sv), jnp.stack(slf), jnp.stack(sh), jnp.stack(sc))
```

```cpp
#include <hip/hip_runtime.h>
#include <hip/hip_bf16.h>
#include <hip/hip_cooperative_groups.h>
#include <cstdio>
#include <cstdint>
namespace cg = cooperative_groups;

#ifndef MK_PER_PHASE
#define MK_PER_PHASE 0
#endif

#define LAS __attribute__((address_space(3)))
typedef unsigned short bf16_t;
typedef short bf16x8 __attribute__((ext_vector_type(8)));
typedef short s16x4 __attribute__((ext_vector_type(4)));
typedef float f32x2 __attribute__((ext_vector_type(2)));
typedef float f32x4 __attribute__((ext_vector_type(4)));
typedef float f32x16 __attribute__((ext_vector_type(16)));
typedef unsigned u32x2 __attribute__((ext_vector_type(2)));
typedef unsigned u32x4 __attribute__((ext_vector_type(4)));

constexpr int DM = 2048, SEQ = 4096, NB = 8, MP = NB * SEQ, MS = 128, MV = MP + MS, NTM = 129, MR = NTM * 256;
constexpr int DSQ = 16, PAST = 2048, NH = 16, HD = 128, DFF = 5632, NMEM = 256, MEMW = 512;
constexpr int NFIN = 6160, NFIN_PAD = 6400;
constexpr float EPS = 1e-6f;
constexpr float INV_SCALE = 11.313708498984761f;
constexpr float SM_SCALE = 0.08838834764831845f;

constexpr size_t O_YP = 0, O_YS = (size_t)MP * DM, O_PK = O_YS + (size_t)MS * DM, O_PV = O_PK + (size_t)MP * DM, O_PLF = O_PV + (size_t)MP * DM,
    O_PMK = O_PLF + (size_t)MP * NH, O_PMV = O_PMK + (size_t)2 * NB * NMEM * MEMW, O_PLH = O_PMV + (size_t)2 * NB * NMEM * MEMW, O_PLC = O_PLH + (size_t)NB * DM,
    O_SK = O_PLC + (size_t)NB * 3 * DM, O_SV = O_SK + (size_t)MS * DM, O_SLF = O_SV + (size_t)MS * DM, O_SLH = O_SLF + (size_t)MS * NH, O_SLC = O_SLH + (size_t)NB * DM,
    O_END = O_SLC + (size_t)NB * 3 * DM;

constexpr size_t al256(size_t x) { return (x + 255) & ~(size_t)255; }
constexpr size_t ACT_B = (size_t)MR * DM * 2;
constexpr size_t WS_WFIN = 0;
constexpr size_t WS_WFOUT = WS_WFIN + (size_t)NFIN_PAD * DM * 2;
constexpr size_t WS_WLIN = WS_WFOUT + (size_t)DM * DM * 2;
constexpr size_t WS_WGATE = WS_WLIN + (size_t)2 * DM * DM * 2;
constexpr size_t WS_WLOUT = WS_WGATE + (size_t)16 * 256 * 256 * 2;
constexpr size_t WS_WXQ = WS_WLOUT + (size_t)DM * DM * 2;
constexpr size_t WS_WXKV = WS_WXQ + (size_t)2 * MEMW * DM * 2;
constexpr size_t WS_WXO = WS_WXKV + (size_t)2 * 2 * MEMW * DM * 2;
constexpr size_t WS_WFFI = WS_WXO + (size_t)2 * DM * MEMW * 2;
constexpr size_t WS_WFFO = WS_WFFI + (size_t)2 * 2 * DFF * DM * 2;
constexpr size_t WS_XB = WS_WFFO + (size_t)2 * DM * DFF * 2;
constexpr size_t WS_BIG = WS_XB + ACT_B;
constexpr size_t WS_Q2 = WS_BIG + 4 * ACT_B;
constexpr size_t WS_MEMN = WS_Q2 + (size_t)MR * MEMW * 2;
constexpr size_t WS_MEMK = WS_MEMN + (size_t)2 * 2048 * DM * 2;
constexpr size_t WS_MEMV = WS_MEMK + (size_t)2 * 2048 * MEMW * 2;
constexpr size_t WS_SS = WS_MEMV + (size_t)2 * 2048 * MEMW * 2;
constexpr size_t WS_BIASP = al256(WS_SS + (size_t)7 * MR * 4);
constexpr int BIASS_LD = 2080;
constexpr size_t WS_BIASS = WS_BIASP + (size_t)NB * NH * SEQ * 4;
constexpr size_t WS_CA = al256(WS_BIASS + (size_t)2 * NB * NH * BIASS_LD * 4);
constexpr size_t WS_CB = WS_CA + (size_t)NB * 64 * DM * 4;
constexpr size_t WS_SPL = WS_CB + (size_t)NB * 64 * DM * 4;
constexpr size_t WS_BAR = al256(WS_SPL + (size_t)DM * 4);
constexpr size_t WS_END = WS_BAR + 16384;
static_assert((size_t)MR * DFF * 2 <= 4 * ACT_B, "H overlay");

constexpr int LDS_BYTES = 147456;

__device__ __forceinline__ unsigned cvt_pk_bf16(float lo, float hi) { unsigned r; asm volatile("v_cvt_pk_bf16_f32 %0, %1, %2" : "=v"(r) : "v"(lo), "v"(hi)); return r; }
__device__ __forceinline__ float bf2f(unsigned short b) { return __uint_as_float((unsigned)b << 16); }
__device__ __forceinline__ float bflo(unsigned w) { return __uint_as_float(w << 16); }
__device__ __forceinline__ float bfhi(unsigned w) { return __uint_as_float(w & 0xffff0000u); }
__device__ __forceinline__ u32x4 pack8f(f32x4 a, f32x4 b) { u32x4 w; w.x = cvt_pk_bf16(a[0], a[1]); w.y = cvt_pk_bf16(a[2], a[3]); w.z = cvt_pk_bf16(b[0], b[1]); w.w = cvt_pk_bf16(b[2], b[3]); return w; }
__device__ __forceinline__ float wave_sum(float v) {
#pragma unroll
    for (int o = 1; o < 64; o <<= 1) v += __shfl_xor(v, o);
    return v;
}
__device__ __forceinline__ float wave_max(float v) {
#pragma unroll
    for (int o = 1; o < 64; o <<= 1) v = fmaxf(v, __shfl_xor(v, o));
    return v;
}
__device__ __forceinline__ float sigmoidf_(float x) { return __builtin_amdgcn_rcpf(1.f + __expf(-x)); }
__device__ __forceinline__ float siluf_(float x) { return x * sigmoidf_(x); }
__device__ __forceinline__ float gelu_tanh_(float x) { return x * sigmoidf_(1.5957691216057308f * (x + 0.044715f * x * x * x)); }
__device__ __forceinline__ float logsigmoid_(float x) { return x < 0.f ? x - log1pf(__expf(x)) : -log1pf(__expf(-x)); }
#define LDS_WAIT() asm volatile("s_waitcnt lgkmcnt(0)" ::: "memory")

namespace pg8 {
#define PG8_LAS __attribute__((address_space(3)))
constexpr int BM = 256, BK = 64, HALF = 128, HTB = HALF * BK * 2, STAGE_BYTES = 8 * HTB, NXCD = 8, WGM = 8;
__host__ __device__ __forceinline__ int lds_byte(int r, int c) { const int st = (r >> 4) * 2 + (c >> 5), rr = r & 15, cc = c & 31, ob = rr * 64 + cc * 2; return st * 1024 + (ob ^ (((ob >> 9) & 1) << 5)); }
__host__ __device__ __forceinline__ void stage_rc(int b, int& R, int& C) { const int st = b / 1024, sb = b % 1024, swz = sb ^ (((sb >> 9) & 1) << 5); R = (st >> 1) * 16 + swz / 64; C = (st & 1) * 32 + (swz % 64) / 2; }
__host__ __device__ __forceinline__ int perm32(int rho) { const int n = rho >> 4, i = rho & 15; return 8 * (i >> 2) + 4 * n + (i & 3); }

struct Unit { int pm, pn; };
struct Gemm { const bf16_t* A; const bf16_t* Bt; int lda, ldb, K, akoff, bdiv, bstride, hpm; };
__device__ __forceinline__ const char* abase(const Gemm& g, const Unit& u) { return (const char*)(g.A + (size_t)u.pm * BM * g.lda + (size_t)(u.pn >> 1) * g.akoff); }
__device__ __forceinline__ const char* bbase(const Gemm& g, const Unit& u) { return (const char*)(g.Bt + ((size_t)u.pn * BM + (size_t)(u.pm / g.bdiv) * g.bstride) * g.ldb); }

struct StaticOrder {
    int nM, nN, nwg, G, c;
    __device__ void init(int nM_, int nN_, int G_, int c_) { nM = nM_; nN = nN_; nwg = nM * nN; G = G_; c = c_; }
    __device__ bool next(int i, Unit& u) const {
        const long L = (long)i * G + c; if (L >= nwg) return false;
        int wgid = (int)L; { const int q = nwg / NXCD, r = nwg % NXCD, xcd = wgid % NXCD, off = wgid / NXCD; wgid = (xcd < r ? xcd * (q + 1) : r * (q + 1) + (xcd - r) * q) + off; }
        const int nig = WGM * nN, gid = wgid / nig, fm = gid * WGM, gsz = (nM - fm) < WGM ? (nM - fm) : WGM;
        u.pm = fm + ((wgid % nig) % gsz); u.pn = (wgid % nig) / gsz; return true;
    }
};

template <class Epi>
__device__ __forceinline__ void gemm_phase(PG8_LAS unsigned char* lds, const Gemm g, const StaticOrder& S, const Epi& E) {
    const int tid = threadIdx.x, wid = __builtin_amdgcn_readfirstlane(tid >> 6), lane = tid & 63, wr = wid >> 2, wc = wid & 3, fr = lane & 15, fq = lane >> 4;
    int K = g.K; asm volatile("" : "+s"(K)); const int nt = K / BK;
    unsigned voffA[2], voffB[2];
#pragma unroll
    for (int i = 0; i < 2; ++i) { int R, C; stage_rc(tid * 16 + i * 8192, R, C); const int Rb = (R & ~31) + perm32(R & 31);
        voffA[i] = (unsigned)(R * g.lda + C) * 2u; voffB[i] = (unsigned)(Rb * g.ldb + C) * 2u; }
    const size_t kstep = (size_t)(BK * 2);
    const size_t hstepA = (size_t)HALF * g.lda * 2, hstepB = (size_t)HALF * g.ldb * 2;
    const unsigned ldsw = (unsigned)wid * 1024u;
    const int aoff = lds_byte(wr * 64 + fr, fq * 8), boff = lds_byte(wc * 32 + fr, fq * 8);
#define PG8_SA(b, h) (((b) * 2 + (h)) * HTB)
#define PG8_SB(b, h) ((4 + (b) * 2 + (h)) * HTB)
#define PG8_STAGE(bufoff, gbase, voff) do { _Pragma("unroll") for (int _i = 0; _i < 2; ++_i) \
        __builtin_amdgcn_global_load_lds((const unsigned*)((const char*)(gbase) + (voff)[_i]), (PG8_LAS unsigned*)(lds + (bufoff) + ldsw + _i * 8192), 16, 0, 0); } while (0)
#define PG8_LDA(dst, b, h) do { _Pragma("unroll") for (int m = 0; m < 4; ++m) _Pragma("unroll") for (int k = 0; k < 2; ++k) dst[m][k] = *(const PG8_LAS bf16x8*)(lds + PG8_SA(b, h) + aoff + m * 2048 + k * 1024); } while (0)
#define PG8_LDB(dst, b, h) do { _Pragma("unroll") for (int n = 0; n < 2; ++n) _Pragma("unroll") for (int k = 0; k < 2; ++k) dst[n][k] = *(const PG8_LAS bf16x8*)(lds + PG8_SB(b, h) + boff + n * 2048 + k * 1024); } while (0)
#define PG8_MMA(ai, bj, At, Bt) do { __builtin_amdgcn_s_setprio(1); _Pragma("unroll") for (int m = 0; m < 4; ++m) _Pragma("unroll") for (int n = 0; n < 2; ++n) _Pragma("unroll") for (int k = 0; k < 2; ++k) \
        acc[ai][bj][m][n] = __builtin_amdgcn_mfma_f32_16x16x32_bf16(Bt[n][k], At[m][k], acc[ai][bj][m][n], 0, 0, 0); __builtin_amdgcn_s_setprio(0); } while (0)
#define PG8_WAIT_V(n) asm volatile("s_waitcnt vmcnt(" #n ")" ::: "memory")
#define PG8_WAIT_L(n) asm volatile("s_waitcnt lgkmcnt(" #n ")" ::: "memory")
#define PG8_BAR __builtin_amdgcn_s_barrier()
#define PG8_SCHED __builtin_amdgcn_sched_barrier(0)
    Unit cur, nxt; int ui = 0;
    if (!S.next(0, cur)) return;
    f32x4 acc[2][2][4][2];
#pragma unroll
    for (int a = 0; a < 2; ++a)
#pragma unroll
        for (int b = 0; b < 2; ++b)
#pragma unroll
            for (int m = 0; m < 4; ++m)
#pragma unroll
                for (int n = 0; n < 2; ++n) acc[a][b][m][n] = (f32x4){0.f, 0.f, 0.f, 0.f};
    bf16x8 At[4][2], B0[2][2], B1[2][2];
    const char* cA = abase(g, cur); const char* cB = bbase(g, cur); bool fullc = cur.pm != g.hpm;
    PG8_STAGE(PG8_SB(0, 0), cB, voffB); PG8_STAGE(PG8_SB(0, 1), cB + hstepB, voffB); PG8_STAGE(PG8_SA(0, 0), cA, voffA); PG8_STAGE(PG8_SA(0, 1), cA + hstepA, voffA);
    if (wr == 1) PG8_BAR;
    PG8_WAIT_V(2); PG8_BAR;
    PG8_STAGE(PG8_SB(1, 0), cB + kstep, voffB); PG8_STAGE(PG8_SA(1, 0), cA + kstep, voffA); PG8_STAGE(PG8_SB(1, 1), cB + hstepB + kstep, voffB);
    PG8_WAIT_V(6); PG8_BAR;
    for (;;) {
        const bool has_next = S.next(ui + 1, nxt);
        const char* nA = has_next ? abase(g, nxt) : cA; const char* nB = has_next ? bbase(g, nxt) : cB;
        for (int t = 0; t < nt; t += 2) {
            const bool last = (t == nt - 2);
            const char* a1 = cA + (size_t)(t + 1) * kstep;
            const char* a2 = last ? nA : cA + (size_t)(t + 2) * kstep; const char* b2 = last ? nB : cB + (size_t)(t + 2) * kstep;
            const char* a3 = a2 + kstep; const char* b3 = b2 + kstep;
            PG8_LDB(B0, 0, 0); PG8_LDB(B1, 0, 1); PG8_SCHED; PG8_LDA(At, 0, 0); PG8_STAGE(PG8_SA(1, 1), a1 + hstepA, voffA);
            PG8_WAIT_V(8); PG8_WAIT_L(0); PG8_BAR; PG8_MMA(0, 0, At, B0); PG8_MMA(0, 1, At, B1); PG8_BAR; PG8_SCHED;
            PG8_LDA(At, 0, 1); PG8_STAGE(PG8_SB(0, 0), b2, voffB); PG8_STAGE(PG8_SB(0, 1), b2 + hstepB, voffB); PG8_STAGE(PG8_SA(0, 0), a2, voffA);
            PG8_WAIT_V(8); PG8_WAIT_L(0); PG8_BAR; if (fullc) { PG8_MMA(1, 0, At, B0); PG8_MMA(1, 1, At, B1); } PG8_BAR; PG8_SCHED;
            PG8_LDB(B0, 1, 0); PG8_LDB(B1, 1, 1); PG8_SCHED; PG8_LDA(At, 1, 0); PG8_STAGE(PG8_SA(0, 1), a2 + hstepA, voffA);
            PG8_WAIT_V(8); PG8_WAIT_L(0); PG8_BAR; PG8_MMA(0, 0, At, B0); PG8_MMA(0, 1, At, B1); PG8_BAR; PG8_SCHED;
            PG8_LDA(At, 1, 1); PG8_STAGE(PG8_SB(1, 0), b3, voffB); PG8_STAGE(PG8_SB(1, 1), b3 + hstepB, voffB); PG8_STAGE(PG8_SA(1, 0), a3, voffA);
            PG8_WAIT_V(8); PG8_WAIT_L(0); PG8_BAR; if (fullc) { PG8_MMA(1, 0, At, B0); PG8_MMA(1, 1, At, B1); } PG8_BAR; PG8_SCHED;
        }
        if (wr == 0) PG8_BAR;
        E(acc, cur, wr, wc, fr, fq);
        if (!has_next) break;
#pragma unroll
        for (int a = 0; a < 2; ++a)
#pragma unroll
            for (int b = 0; b < 2; ++b)
#pragma unroll
                for (int m = 0; m < 4; ++m)
#pragma unroll
                    for (int n = 0; n < 2; ++n) acc[a][b][m][n] = (f32x4){0.f, 0.f, 0.f, 0.f};
        cur = nxt; cA = nA; cB = nB; ++ui; fullc = cur.pm != g.hpm;
        if (wr == 1) PG8_BAR;
    }
    PG8_WAIT_V(0);
    PG8_BAR;
#undef PG8_SA
#undef PG8_SB
#undef PG8_STAGE
#undef PG8_LDA
#undef PG8_LDB
#undef PG8_MMA
#undef PG8_WAIT_V
#undef PG8_WAIT_L
#undef PG8_BAR
#undef PG8_SCHED
}

typedef const f32x4 (&AccT)[2][2][4][2];
__device__ __forceinline__ float rstd_of(const float* ss, int row) { return __builtin_amdgcn_rsqf(ss[row] * (1.0f / DM) + EPS); }

struct EpiFoxIn {
    const float* ss; bf16_t* Qb; bf16_t* Kb; bf16_t* Vb; float* out; const float* b_f;
    __device__ __forceinline__ void operator()(AccT acc, const Unit& u, int wr, int wc, int fr, int fq) const {
        const int row0 = u.pm * BM + wr * 64 + fr;
        if (u.pn < 24) {
            const int t = u.pn >> 3; const int colt = (u.pn & 7) * BM + wc * 32 + 8 * fq;
            bf16_t* bb = Qb + (size_t)t * (ACT_B / 2);
#pragma unroll
            for (int ai = 0; ai < 2; ++ai)
#pragma unroll
                for (int m = 0; m < 4; ++m) { const int row = row0 + ai * HALF + m * 16; const float rs = rstd_of(ss, row);
                    float* fo = nullptr;
                    if (t >= 1) { if (row < MP) { if ((row & (SEQ - 1)) < 64) fo = out + O_PK + (size_t)(t - 1) * ((size_t)MP * DM) + (size_t)row * DM; } else if (row < MV) fo = out + O_SK + (size_t)(t - 1) * ((size_t)MS * DM) + (size_t)(row - MP) * DM; }
#pragma unroll
                    for (int bj = 0; bj < 2; ++bj) { const f32x4 v0 = acc[ai][bj][m][0] * rs, v1 = acc[ai][bj][m][1] * rs; const int col = colt + bj * HALF;
                        *(u32x4*)(bb + (size_t)row * DM + col) = pack8f(v0, v1);
                        if (fo) { __builtin_nontemporal_store(v0, (f32x4*)(fo + col)); __builtin_nontemporal_store(v1, (f32x4*)(fo + col + 4)); } } }
        } else if (wc == 0 && fq < 2) {
            const int col = 8 * fq; const f32x4 b0 = *(const f32x4*)(b_f + col), b1 = *(const f32x4*)(b_f + col + 4);
#pragma unroll
            for (int ai = 0; ai < 2; ++ai)
#pragma unroll
                for (int m = 0; m < 4; ++m) { const int row = row0 + ai * HALF + m * 16; const float rs = rstd_of(ss, row);
                    float* fo = nullptr; if (row < MP) fo = out + O_PLF + (size_t)row * NH; else if (row < MV) fo = out + O_SLF + (size_t)(row - MP) * NH;
                    if (fo) { f32x4 v0 = acc[ai][0][m][0] * rs + b0, v1 = acc[ai][0][m][1] * rs + b1;
#pragma unroll
                        for (int j = 0; j < 4; ++j) { v0[j] = logsigmoid_(v0[j]); v1[j] = logsigmoid_(v1[j]); }
                        *(f32x4*)(fo + col) = v0; *(f32x4*)(fo + col + 4) = v1; } }
        }
    }
};
struct EpiRes {
    bf16_t* xb; float* ss_out;
    __device__ __forceinline__ void operator()(AccT acc, const Unit& u, int wr, int wc, int fr, int fq) const {
        const int row0 = u.pm * BM + wr * 64 + fr; const int colt = u.pn * BM + wc * 32 + 8 * fq;
        u32x4 xo[2][4][2];
#pragma unroll
        for (int ai = 0; ai < 2; ++ai)
#pragma unroll
            for (int m = 0; m < 4; ++m)
#pragma unroll
                for (int bj = 0; bj < 2; ++bj) xo[ai][m][bj] = *(const u32x4*)(xb + (size_t)(row0 + ai * HALF + m * 16) * DM + colt + bj * HALF);
        asm volatile("" ::: "memory");
        float sq[2][4];
#pragma unroll
        for (int ai = 0; ai < 2; ++ai)
#pragma unroll
            for (int m = 0; m < 4; ++m) { const int row = row0 + ai * HALF + m * 16;
                float s = 0.f;
#pragma unroll
                for (int bj = 0; bj < 2; ++bj) { bf16_t* px = xb + (size_t)row * DM + colt + bj * HALF; const u32x4 x4 = xo[ai][m][bj];
                    f32x4 v0 = acc[ai][bj][m][0], v1 = acc[ai][bj][m][1];
                    v0[0] += bflo(x4[0]); v0[1] += bfhi(x4[0]); v0[2] += bflo(x4[1]); v0[3] += bfhi(x4[1]);
                    v1[0] += bflo(x4[2]); v1[1] += bfhi(x4[2]); v1[2] += bflo(x4[3]); v1[3] += bfhi(x4[3]);
                    *(u32x4*)px = pack8f(v0, v1);
                    s += (v0[0] * v0[0] + v0[1] * v0[1]) + (v0[2] * v0[2] + v0[3] * v0[3]) + (v1[0] * v1[0] + v1[1] * v1[1]) + (v1[2] * v1[2] + v1[3] * v1[3]); }
                s += __shfl_xor(s, 16); s += __shfl_xor(s, 32);
                sq[ai][m] = s; }
        const float k0 = fq == 0 ? 1.f : 0.f, k1 = fq == 1 ? 1.f : 0.f, k2 = fq == 2 ? 1.f : 0.f, k3 = fq == 3 ? 1.f : 0.f;
#pragma unroll
        for (int ai = 0; ai < 2; ++ai) { const float v = (k0 * sq[ai][0] + k1 * sq[ai][1]) + (k2 * sq[ai][2] + k3 * sq[ai][3]);
            const int row = row0 + ai * HALF + fq * 16;
            if (row < MV) __hip_atomic_fetch_add(ss_out + row, v, __ATOMIC_RELAXED, __HIP_MEMORY_SCOPE_AGENT); }
    }
};
struct EpiScale {
    const float* ss; bf16_t* O; int ldc;
    __device__ __forceinline__ void operator()(AccT acc, const Unit& u, int wr, int wc, int fr, int fq) const {
        const int row0 = u.pm * BM + wr * 64 + fr; const int colt = u.pn * BM + wc * 32 + 8 * fq;
#pragma unroll
        for (int ai = 0; ai < 2; ++ai)
#pragma unroll
            for (int m = 0; m < 4; ++m) { const int row = row0 + ai * HALF + m * 16; const float rs = rstd_of(ss, row);
#pragma unroll
                for (int bj = 0; bj < 2; ++bj) *(u32x4*)(O + (size_t)row * ldc + colt + bj * HALF) = pack8f(acc[ai][bj][m][0] * rs, acc[ai][bj][m][1] * rs); }
    }
};
struct EpiSwiglu {
    const float* ss; bf16_t* H;
    __device__ __forceinline__ void operator()(AccT acc, const Unit& u, int wr, int wc, int fr, int fq) const {
        const int row0 = u.pm * BM + wr * 64 + fr; const int col = u.pn * HALF + wc * 32 + 8 * fq;
#pragma unroll
        for (int ai = 0; ai < 2; ++ai)
#pragma unroll
            for (int m = 0; m < 4; ++m) { const int row = row0 + ai * HALF + m * 16; const float rs = rstd_of(ss, row);
                f32x4 o0, o1;
#pragma unroll
                for (int j = 0; j < 4; ++j) { o0[j] = siluf_(acc[ai][0][m][0][j] * rs) * (acc[ai][1][m][0][j] * rs); o1[j] = siluf_(acc[ai][0][m][1][j] * rs) * (acc[ai][1][m][1][j] * rs); }
                *(u32x4*)(H + (size_t)row * DFF + col) = pack8f(o0, o1); }
    }
};
struct EpiLruIn {
    const float* ss; bf16_t* G; bf16_t* U; float* out;
    __device__ __forceinline__ void operator()(AccT acc, const Unit& u, int wr, int wc, int fr, int fq) const {
        const int row0 = u.pm * BM + wr * 64 + fr; const bool isg = u.pn < 8; const int colt = (u.pn & 7) * BM + wc * 32 + 8 * fq;
#pragma unroll
        for (int ai = 0; ai < 2; ++ai)
#pragma unroll
            for (int m = 0; m < 4; ++m) { const int row = row0 + ai * HALF + m * 16; const float rs = rstd_of(ss, row);
                float* fo = nullptr;
                if (!isg) { if (row < MP) { const int t = row & (SEQ - 1); if (t >= SEQ - 3) fo = out + O_PLC + ((size_t)(row >> 12) * 3 + (t - (SEQ - 3))) * DM; }
                            else if (row < MV) { const int t = (row - MP) & 15; if (t >= 13) fo = out + O_SLC + ((size_t)((row - MP) >> 4) * 3 + (t - 13)) * DM; } }
#pragma unroll
                for (int bj = 0; bj < 2; ++bj) { f32x4 v0 = acc[ai][bj][m][0] * rs, v1 = acc[ai][bj][m][1] * rs; const int col = colt + bj * HALF;
                    if (isg) {
#pragma unroll
                        for (int j = 0; j < 4; ++j) { v0[j] = gelu_tanh_(v0[j]); v1[j] = gelu_tanh_(v1[j]); }
                        *(u32x4*)(G + (size_t)row * DM + col) = pack8f(v0, v1);
                    } else { *(u32x4*)(U + (size_t)row * DM + col) = pack8f(v0, v1);
                        if (fo) { *(f32x4*)(fo + col) = v0; *(f32x4*)(fo + col + 4) = v1; } } } }
    }
};
struct EpiGates {
    const bf16_t* UC; const float* b_a; const float* b_x; const float* spl; bf16_t* LA; bf16_t* BB;
    __device__ __forceinline__ void operator()(AccT acc, const Unit& u, int wr, int wc, int fr, int fq) const {
        const int row0 = u.pm * BM + wr * 64 + fr; const int ch = u.pn * HALF + wc * 32 + 8 * fq;
        u32x4 ucw[2][4];
#pragma unroll
        for (int ai = 0; ai < 2; ++ai)
#pragma unroll
            for (int m = 0; m < 4; ++m) ucw[ai][m] = *(const u32x4*)(UC + (size_t)(row0 + ai * HALF + m * 16) * DM + ch);
        const f32x4 ba0 = *(const f32x4*)(b_a + ch), ba1 = *(const f32x4*)(b_a + ch + 4), bx0 = *(const f32x4*)(b_x + ch), bx1 = *(const f32x4*)(b_x + ch + 4);
        const f32x4 sp0 = *(const f32x4*)(spl + ch), sp1 = *(const f32x4*)(spl + ch + 4);
        asm volatile("" ::: "memory");
#pragma unroll
        for (int ai = 0; ai < 2; ++ai)
#pragma unroll
            for (int m = 0; m < 4; ++m) { int row = row0 + ai * HALF + m * 16; asm volatile("" : "+v"(row));
                f32x4 la0, la1, b0, b1;
#pragma unroll
                for (int j = 0; j < 4; ++j) {
                    la0[j] = -sp0[j] * sigmoidf_(acc[ai][0][m][0][j] + ba0[j]); la1[j] = -sp1[j] * sigmoidf_(acc[ai][0][m][1][j] + ba1[j]);
                    const unsigned w0 = ucw[ai][m][j >> 1], w1 = ucw[ai][m][2 + (j >> 1)];
                    b0[j] = sigmoidf_(acc[ai][1][m][0][j] + bx0[j]) * ((j & 1) ? bfhi(w0) : bflo(w0));
                    b1[j] = sigmoidf_(acc[ai][1][m][1][j] + bx1[j]) * ((j & 1) ? bfhi(w1) : bflo(w1)); }
                *(u32x4*)(LA + (size_t)row * DM + ch) = pack8f(la0, la1); *(u32x4*)(BB + (size_t)row * DM + ch) = pack8f(b0, b1); }
    }
};
struct EpiMemKV {
    float* out; bf16_t* KB; bf16_t* VB;
    __device__ __forceinline__ void operator()(AccT acc, const Unit& u, int wr, int wc, int fr, int fq) const {
        const int row0 = u.pm * BM + wr * 64 + fr; const bool isk = u.pn < 2; const int colt = (u.pn & 1) * BM + wc * 32 + 8 * fq;
        float* fo = out + O_PMK + (isk ? (size_t)0 : (size_t)(O_PMV - O_PMK)); bf16_t* bo = KB + (isk ? (size_t)0 : (size_t)2 * 2048 * MEMW);
#pragma unroll
        for (int ai = 0; ai < 2; ++ai)
#pragma unroll
            for (int m = 0; m < 4; ++m) { const int row = row0 + ai * HALF + m * 16;
#pragma unroll
                for (int bj = 0; bj < 2; ++bj) { const f32x4 v0 = acc[ai][bj][m][0], v1 = acc[ai][bj][m][1]; const int col = colt + bj * HALF;
                    *(u32x4*)(bo + (size_t)row * MEMW + col) = pack8f(v0, v1);
                    *(f32x4*)(fo + (size_t)row * MEMW + col) = v0; *(f32x4*)(fo + (size_t)row * MEMW + col + 4) = v1; } }
    }
};
}

namespace att {
using bf16 = __hip_bfloat16;
constexpr int D = 128, NW = 8, QBLK = 32, KVBLK = 64, QB = NW * QBLK;
constexpr int SHM_V = KVBLK * D * 2, SHM_K = KVBLK * D * 2;
constexpr int LDS_WS = 2 * SHM_V + 2 * SHM_K, LDS_BIAS = LDS_WS + NW * 64 * 4, ATT_LDS_BYTES = LDS_BIAS + 4096 * 4;
constexpr float SCALE = SM_SCALE, THR = 16.f;
#define KSWZ(row, colB) ((row) * 256 + ((colB) ^ (((row) & 7) << 4)))
#define SBAR() __builtin_amdgcn_sched_barrier(0)
__device__ __forceinline__ int v_st(int k, int c) { const int kk = (k & ~0xC) | ((k & 4) << 1) | ((k & 8) >> 1); return ((kk >> 3) * 4 + (c >> 5)) * 512 + ((kk & 7) * 32 + (c & 31)) * 2; }
__device__ __forceinline__ int v_rd_base(int lane) { return ((lane & 3) << 3) | (((lane >> 2) & 3) << 6) | (((lane >> 4) & 1) << 5) | (((lane >> 5) & 1) << 8); }
constexpr int v_rd_off(int d0, int ks, int half) { return d0 * 512 + ks * 4096 + half * 2048; }
__device__ __forceinline__ int crow(int r, int hi) { return (r & 3) + 8 * (r >> 2) + 4 * hi; }
__device__ __forceinline__ bf16x8 load8(const bf16* p) { return *reinterpret_cast<const bf16x8*>(p); }
__device__ __forceinline__ void mask_tile(f32x16& p0, f32x16& p1, int dq, unsigned W) {
    const float NEG = -__builtin_inff();
#pragma unroll
    for (int r = 0; r < 16; ++r) { const int c = (r & 3) + 8 * (r >> 2);
        if ((unsigned)(dq - c) >= W) p0[r] = NEG;
        if ((unsigned)(dq - c - 32) >= W) p1[r] = NEG; }
}
__device__ __forceinline__ void partialSM(f32x16& p0, f32x16& p1, float& m_reg, float& mn, float& alpha) {
    float pmax = p0[0];
#pragma unroll
    for (int r = 1; r < 16; ++r) pmax = fmaxf(pmax, p0[r]);
#pragma unroll
    for (int r = 0; r < 16; ++r) pmax = fmaxf(pmax, p1[r]);
    { auto rr = __builtin_amdgcn_permlane32_swap(__float_as_uint(pmax), __float_as_uint(pmax), false, false);
      pmax = fmaxf(__uint_as_float(rr[0]), __uint_as_float(rr[1])); }
    constexpr float C2 = 1.4426950408889634f * SCALE;
    if (__builtin_expect(__all((pmax - m_reg) * SCALE <= THR), 1)) { mn = m_reg; alpha = 1.f; }
    else { mn = fmaxf(m_reg, pmax); alpha = __builtin_amdgcn_exp2f((m_reg - mn) * C2); m_reg = mn; }
    const float mnL = -mn * C2;
#pragma unroll
    for (int r = 0; r < 16; ++r) p0[r] = fmaf(p0[r], C2, mnL);
#pragma unroll
    for (int r = 0; r < 16; ++r) p1[r] = fmaf(p1[r], C2, mnL);
#pragma unroll
    for (int r = 0; r < 16; ++r) p0[r] = __builtin_amdgcn_exp2f(p0[r]);
}
__device__ __forceinline__ void finishSM(f32x16& p0, f32x16& p1, float alpha, float& l_reg, bf16x8& pa0, bf16x8& pa1, bf16x8& pa2, bf16x8& pa3) {
#pragma unroll
    for (int r = 0; r < 16; ++r) p1[r] = __builtin_amdgcn_exp2f(p1[r]);
    float ps = 0;
#pragma unroll
    for (int r = 0; r < 16; ++r) ps += p0[r];
#pragma unroll
    for (int r = 0; r < 16; ++r) ps += p1[r];
    { auto rr = __builtin_amdgcn_permlane32_swap(__float_as_uint(ps), __float_as_uint(ps), false, false);
      ps = __uint_as_float(rr[0]) + __uint_as_float(rr[1]); }
    l_reg = l_reg * alpha + ps;
#define PK4(P, B_, OUT) do { unsigned a0 = cvt_pk_bf16(P[B_+0], P[B_+1]), a1 = cvt_pk_bf16(P[B_+2], P[B_+3]);                          \
        unsigned b0 = cvt_pk_bf16(P[B_+4], P[B_+5]), b1 = cvt_pk_bf16(P[B_+6], P[B_+7]);                                             \
        auto r0 = __builtin_amdgcn_permlane32_swap(a0, b0, false, false); auto r1 = __builtin_amdgcn_permlane32_swap(a1, b1, false, false); \
        u32x4 w = {r0[0], r1[0], r0[1], r1[1]}; OUT = *reinterpret_cast<bf16x8*>(&w); } while (0)
    PK4(p0, 0, pa0); PK4(p0, 8, pa1); PK4(p1, 0, pa2); PK4(p1, 8, pa3);
#undef PK4
}
template <int KB, bool HB>
__device__ __forceinline__ void qkt(f32x16& p0, f32x16& p1, const char* lds, int r32, int hi, const bf16x8* qr, int kbase) {
    const char* K_lds = lds + 2 * SHM_V;
    if (HB) { const char* bl = lds + LDS_BIAS + kbase * 4 + hi * 16;
#pragma unroll
        for (int j = 0; j < 4; ++j) { const f32x4 a = *(const f32x4*)(bl + j * 32), b = *(const f32x4*)(bl + 128 + j * 32);
#pragma unroll
            for (int i = 0; i < 4; ++i) { p0[4 * j + i] = a[i]; p1[4 * j + i] = b[i]; } }
    } else { p0 = f32x16{}; p1 = f32x16{}; }
    const char* kb[4];
#pragma unroll
    for (int dd = 0; dd < 4; ++dd) kb[dd] = K_lds + KB * SHM_K + KSWZ(r32, (dd * 16 + hi * 8) * 2);
#pragma unroll
    for (int d0 = 0; d0 < 8; ++d0) { const char* a = kb[d0 & 3] + (d0 >> 2) * 128;
        bf16x8 b0 = *reinterpret_cast<const bf16x8*>(a);
        bf16x8 b1 = *reinterpret_cast<const bf16x8*>(a + 32 * 256);
        p0 = __builtin_amdgcn_mfma_f32_32x32x16_bf16(b0, qr[d0], p0, 0, 0, 0);
        p1 = __builtin_amdgcn_mfma_f32_32x32x16_bf16(b1, qr[d0], p1, 0, 0, 0); }
}
template <int VB>
__device__ __forceinline__ void pv_tile(f32x16* o, int vb0, bf16x8 pa0, bf16x8 pa1, bf16x8 pa2, bf16x8 pa3) {
#define TRRD(dst, off) asm volatile("ds_read_b64_tr_b16 %0, %1 offset:%2" : "=&v"(dst) : "v"(vb0), "i"(off) : "memory")
#define PV_D0(d0) do { s16x4 l0, l1, l2, l3, h0, h1, h2, h3; constexpr int b_ = VB * SHM_V + v_rd_off(d0, 0, 0); \
        TRRD(l0, b_); TRRD(h0, b_ + 2048); TRRD(l1, b_ + 4096); TRRD(h1, b_ + 6144); TRRD(l2, b_ + 8192); TRRD(h2, b_ + 10240); TRRD(l3, b_ + 12288); TRRD(h3, b_ + 14336); \
        asm volatile("s_waitcnt lgkmcnt(0)" ::: "memory"); SBAR();   \
        o[d0] = __builtin_amdgcn_mfma_f32_32x32x16_bf16(pa0, (bf16x8){l0[0], l0[1], l0[2], l0[3], h0[0], h0[1], h0[2], h0[3]}, o[d0], 0, 0, 0);   \
        o[d0] = __builtin_amdgcn_mfma_f32_32x32x16_bf16(pa1, (bf16x8){l1[0], l1[1], l1[2], l1[3], h1[0], h1[1], h1[2], h1[3]}, o[d0], 0, 0, 0);   \
        o[d0] = __builtin_amdgcn_mfma_f32_32x32x16_bf16(pa2, (bf16x8){l2[0], l2[1], l2[2], l2[3], h2[0], h2[1], h2[2], h2[3]}, o[d0], 0, 0, 0);   \
        o[d0] = __builtin_amdgcn_mfma_f32_32x32x16_bf16(pa3, (bf16x8){l3[0], l3[1], l3[2], l3[3], h3[0], h3[1], h3[2], h3[3]}, o[d0], 0, 0, 0); } while (0)
    PV_D0(0); PV_D0(1); PV_D0(2); PV_D0(3);
#undef PV_D0
#undef TRRD
}
struct BlockRef { const bf16* Q; const bf16* K; const bf16* V; bf16* O; const float* cb; float* fk; float* fv; int P0; };
struct Seam { bf16x8 qr[8]; bf16x8 st_v0, st_v1, st_k0, st_k1; };
__device__ __forceinline__ int swa_jlo(int P0, int W) { const int lowk = P0 - W + 1; return lowk > 0 ? lowk / KVBLK : 0; }
#define ROW(p, k0, rr) ((p) + (size_t)((k0) + (rr)) * RSK + sc)
#define VMW() asm volatile("s_waitcnt vmcnt(0)" ::: "memory")
#define VMWN(n) asm volatile("s_waitcnt vmcnt(%0)" :: "i"(n) : "memory")
#define STG_IDX() int t_ = threadIdx.x; asm volatile("" : "+v"(t_)); const int sr = t_ >> 4, sc = (t_ & 15) * 8
#define SLOAD_H(R_, k0) do { STG_IDX(); S.st_v0 = load8(ROW((R_).V, k0, sr)); S.st_v1 = load8(ROW((R_).V, k0, 32 + sr));              \
                         S.st_k0 = load8(ROW((R_).K, k0, sr)); S.st_k1 = load8(ROW((R_).K, k0, 32 + sr)); } while (0)
#define SWRITE_HK(bf) do { STG_IDX(); const int kws = KSWZ(sr, sc * 2); *(bf16x8*)(K_lds + (bf) * SHM_K + kws) = S.st_k0; *(bf16x8*)(K_lds + (bf) * SHM_K + kws + 32 * 256) = S.st_k1; } while (0)
#define SWRITE_HV(bf) do { STG_IDX(); const int vst0 = v_st(sr, sc), vst1 = v_st(32 + sr, sc); *(bf16x8*)(V_lds + (bf) * SHM_V + vst0) = S.st_v0; *(bf16x8*)(V_lds + (bf) * SHM_V + vst1) = S.st_v1; } while (0)
#define SWRITE_H(bf) do { SWRITE_HV(bf); SWRITE_HK(bf); } while (0)
#define BF8_TO_F32_STORE(dst, v8) do { const u32x4 w_ = __builtin_bit_cast(u32x4, v8); \
        __builtin_nontemporal_store((f32x4){bflo(w_[0]), bfhi(w_[0]), bflo(w_[1]), bfhi(w_[1])}, (f32x4*)(dst)); \
        __builtin_nontemporal_store((f32x4){bflo(w_[2]), bfhi(w_[2]), bflo(w_[3]), bfhi(w_[3])}, (f32x4*)(dst) + 1); } while (0)
#define KV_OUT(k0) do { if (HB) { if ((k0) >= cur.P0) { STG_IDX(); float* dk_ = cur.fk + (size_t)((k0) + sr) * RSK + sc; float* dv_ = cur.fv + (size_t)((k0) + sr) * RSK + sc; \
        BF8_TO_F32_STORE(dk_, S.st_k0); BF8_TO_F32_STORE(dk_ + (size_t)32 * RSK, S.st_k1); BF8_TO_F32_STORE(dv_, S.st_v0); BF8_TO_F32_STORE(dv_ + (size_t)32 * RSK, S.st_v1); } } } while (0)
template <int RSQ, int RSK, bool HB>
__device__ __forceinline__ void att_prime(const BlockRef& cur, int W, char* lds, Seam& S) {
    const int tid = threadIdx.x, wid = __builtin_amdgcn_readfirstlane(tid >> 6), lane = tid & 63, r32 = lane & 31, hi = lane >> 5;
    char* K_lds = lds + 2 * SHM_V;
    const int kb0 = swa_jlo(cur.P0, W) * KVBLK;
#pragma unroll
    for (int d0 = 0; d0 < 8; ++d0) S.qr[d0] = load8(cur.Q + (size_t)(wid * QBLK + r32) * RSQ + d0 * 16 + hi * 8);
    SLOAD_H(cur, kb0); VMW(); SWRITE_HK(0);
    __syncthreads();
}
template <int RSQ, int RSK, bool HB>
__device__ __forceinline__ void att_block(const BlockRef& cur, const BlockRef& nxt, int skv, int W, char* lds, Seam& S) {
    const int tid = threadIdx.x, wid = __builtin_amdgcn_readfirstlane(tid >> 6), lane = tid & 63, r32 = lane & 31, hi = lane >> 5;
    const int j_lo = swa_jlo(cur.P0, W);
    int j_hi = (cur.P0 + QB - 1) / KVBLK + 1; if (j_hi > skv / KVBLK) j_hi = skv / KVBLK;
    const int NT = j_hi - j_lo;
    const int kbn = swa_jlo(nxt.P0, W) * KVBLK;
    const int qlo = cur.P0 + wid * QBLK, qm = qlo + r32 - 4 * hi;
    char* V_lds = lds; char* K_lds = lds + 2 * SHM_V;
    float* ws = (float*)(lds + LDS_WS) + wid * 64; float* li_l = ws, * al_l = ws + 32;
    float m_reg = -1e30f, l_reg = 0; f32x16 o[4] = {};
    const int vb0 = (int)(uintptr_t)V_lds + v_rd_base(lane);
#define RESC(a) do { if (__any((a) < 1.f)) { if (hi == 0) al_l[r32] = (a); asm volatile("s_waitcnt lgkmcnt(0)" ::: "memory");              \
                     _Pragma("unroll") for (int d_ = 0; d_ < 4; ++d_) _Pragma("unroll") for (int r = 0; r < 16; ++r) o[d_][r] *= al_l[crow(r, hi)]; } } while (0)
#define KBASE(t) ((j_lo + (t)) * KVBLK)
#define MASKT(P0_, P1_, t) do { const int kb_ = KBASE(t); if (kb_ + KVBLK - 1 > qlo || kb_ <= qlo + QBLK - 1 - W) mask_tile(P0_, P1_, qm - kb_, (unsigned)W); } while (0)
    constexpr int NQL = 8;
#define SEAM_K0() do { VMWN(NQL); SWRITE_HK(0); SBAR(); } while (0)
    f32x16 pA0, pA1, pB0, pB1; float mnA, mnB, alA, alB; bf16x8 pa0, pa1, pa2, pa3;
    SWRITE_HV(0); SBAR();
    if (NT > 1) SLOAD_H(cur, KBASE(1));
    SBAR(); qkt<0, HB>(pA0, pA1, lds, r32, hi, S.qr, KBASE(0));
    MASKT(pA0, pA1, 0); partialSM(pA0, pA1, m_reg, mnA, alA);
    if (NT > 1) { VMW(); SWRITE_H(1); KV_OUT(KBASE(1)); }
    __syncthreads();
#define HALF_STEP(PX0, PX1, mnX, alX, PY0, PY1, alY, t, KB, VB, SB) do {                                                      \
        SBAR(); qkt<KB, HB>(PX0, PX1, lds, r32, hi, S.qr, KBASE(t));                                             \
        finishSM(PY0, PY1, alY, l_reg, pa0, pa1, pa2, pa3); SBAR();                                                           \
        if ((t) + 1 < NT) { SLOAD_H(cur, KBASE((t) + 1)); SBAR(); }                                               \
        pv_tile<VB>(o, vb0, pa0, pa1, pa2, pa3); MASKT(PX0, PX1, (t)); partialSM(PX0, PX1, m_reg, mnX, alX);                                        \
        __syncthreads();                                                                                                      \
        if ((t) + 1 < NT) { VMW(); SWRITE_H(SB); KV_OUT(KBASE((t) + 1)); }                                                                          \
        RESC(alX); __syncthreads(); } while (0)
    for (int t = 1; t + 1 < NT; t += 2) {
        HALF_STEP(pB0, pB1, mnB, alB, pA0, pA1, alA, t, 1, 0, 0);
        HALF_STEP(pA0, pA1, mnA, alA, pB0, pB1, alB, t + 1, 0, 1, 1);
    }
    const bool even = (NT & 1) == 0;
    if (even) { SBAR(); qkt<1, HB>(pB0, pB1, lds, r32, hi, S.qr, KBASE(NT - 1)); SBAR(); }
    SLOAD_H(nxt, kbn); SBAR();
#pragma unroll
    for (int d0 = 0; d0 < 8; ++d0) S.qr[d0] = load8(nxt.Q + (size_t)(wid * QBLK + r32) * RSQ + d0 * 16 + hi * 8);
    SBAR();
    finishSM(pA0, pA1, alA, l_reg, pa0, pa1, pa2, pa3); SBAR();
    pv_tile<0>(o, vb0, pa0, pa1, pa2, pa3);
    if (even) { MASKT(pB0, pB1, NT - 1); partialSM(pB0, pB1, m_reg, mnB, alB); __syncthreads(); RESC(alB);
        finishSM(pB0, pB1, alB, l_reg, pa0, pa1, pa2, pa3); SBAR(); pv_tile<1>(o, vb0, pa0, pa1, pa2, pa3); }
    SBAR(); SEAM_K0();
    if (hi == 0) li_l[r32] = l_reg; asm volatile("s_waitcnt lgkmcnt(0)" ::: "memory");
    float rli[16];
#pragma unroll
    for (int r = 0; r < 16; ++r) rli[r] = __builtin_amdgcn_rcpf(li_l[crow(r, hi)]);
    bf16* Ow = cur.O + (size_t)(wid * QBLK) * RSQ;
    { constexpr int SW = 72; unsigned short* stg = (unsigned short*)(lds + ATT_LDS_BYTES) + wid * (32 * SW);
#pragma unroll
      for (int p = 0; p < 2; ++p) {
#pragma unroll
        for (int r = 0; r < 16; ++r) { const int orow = crow(r, hi);
#pragma unroll
            for (int dd = 0; dd < 2; ++dd) stg[orow * SW + dd * 32 + r32] = (unsigned short)(cvt_pk_bf16(o[2 * p + dd][r] * rli[r], 0.f) & 0xffffu); }
        asm volatile("s_waitcnt lgkmcnt(0)" ::: "memory");
#pragma unroll
        for (int i = 0; i < 4; ++i) { const int row = i * 8 + (lane >> 3), ch = lane & 7; const u32x4 v = *(const u32x4*)(stg + row * SW + ch * 8);
            *(u32x4*)(Ow + (size_t)row * RSQ + p * 64 + ch * 8) = v; }
        asm volatile("s_waitcnt lgkmcnt(0)" ::: "memory");
      } }
    __syncthreads();
#undef RESC
#undef KBASE
#undef MASKT
#undef SEAM_K0
#undef HALF_STEP
}
#undef ROW
#undef VMW
#undef VMWN
#undef SLOAD_H
#undef STG_IDX
#undef SWRITE_HK
#undef SWRITE_HV
#undef SWRITE_H
#undef KV_OUT
#undef BF8_TO_F32_STORE
#undef SBAR
#undef KSWZ
}

constexpr int SA_SP = 2096;
__device__ __forceinline__ void small_attn(char* lds, const bf16_t* Qp, int rsq, const float* cK, const float* cV, int cstride, int ncache,
                                           const float* nK, const float* nV, int nstride, int nnew, const float* lfc, const float* lfn, bf16_t* Op, int t_lo = 0, int t_hi = -1, float* part = nullptr) {
    const int tid = threadIdx.x, wid = __builtin_amdgcn_readfirstlane(tid >> 6), lane = tid & 63, fr = lane & 15, fq = lane >> 4;
    float* Sx = (float*)lds; float* Lr = Sx + 16 * SA_SP; float* Wt = Lr + 16; float* Bs = Wt + 16;
    const bool hb = lfc != nullptr;
    if (hb) {
        float l4[4]; float sm = 0.f;
#pragma unroll
        for (int i = 0; i < 4; ++i) { l4[i] = lfc[(size_t)(4 * tid + i) * NH]; sm += l4[i]; }
        float inc = sm;
#pragma unroll
        for (int o = 1; o < 64; o <<= 1) { const float t = __shfl_up(inc, o); if (lane >= o) inc += t; }
        if (lane == 63) Wt[wid] = inc;
        __syncthreads();
        float c = inc - sm;
        for (int w = 0; w < wid; ++w) c += Wt[w];
#pragma unroll
        for (int i = 0; i < 4; ++i) { c += l4[i]; Bs[4 * tid + i] = -c; }
        if (tid < nnew) { float t = 0.f; for (int w = 0; w < 8; ++w) t += Wt[w]; for (int k = 0; k <= tid; ++k) t += lfn[(size_t)k * NH]; Bs[ncache + tid] = -t; }
        __syncthreads();
    }
    const int nkeys = ncache + nnew, ntile = t_hi < 0 ? (nkeys >> 4) : t_hi; float* Mr = (float*)lds + 16 * SA_SP + 32 + 2080;
    bf16x8 qa[4];
#pragma unroll
    for (int ks = 0; ks < 4; ++ks) qa[ks] = *(const bf16x8*)(Qp + (size_t)fr * rsq + ks * 32 + fq * 8);
    for (int tile0 = t_lo + wid; tile0 < ntile; tile0 += 16) {
        f32x4 ka[2][8];
#pragma unroll
        for (int u = 0; u < 2; ++u) { int tile = tile0 + 8 * u; if (tile >= ntile) tile = tile0; const int key = tile * 16 + fr;
            const float* kp = key < ncache ? cK + (size_t)key * cstride : nK + (size_t)(key - ncache) * nstride;
#pragma unroll
            for (int ks = 0; ks < 4; ++ks) { ka[u][2 * ks] = *(const f32x4*)(kp + ks * 32 + fq * 8); ka[u][2 * ks + 1] = *(const f32x4*)(kp + ks * 32 + fq * 8 + 4); } }
#pragma unroll
        for (int u = 0; u < 2; ++u) { const int tile = tile0 + 8 * u; if (tile < ntile) { const int key = tile * 16 + fr;
            f32x4 acc = {0.f, 0.f, 0.f, 0.f};
#pragma unroll
            for (int ks = 0; ks < 4; ++ks) { const u32x4 w = pack8f(ka[u][2 * ks], ka[u][2 * ks + 1]); acc = __builtin_amdgcn_mfma_f32_16x16x32_bf16(qa[ks], *reinterpret_cast<const bf16x8*>(&w), acc, 0, 0, 0); }
            const float bs = hb ? Bs[key] : 0.f;
#pragma unroll
            for (int r = 0; r < 4; ++r) { const int q = fq * 4 + r; float sc = acc[r] * SM_SCALE + bs;
                if (key >= ncache && (key - ncache) > q) sc = -__builtin_inff();
                Sx[q * SA_SP + key] = sc; } } }
    }
    __syncthreads();
#pragma unroll
    for (int qq = 0; qq < 2; ++qq) { const int q = wid * 2 + qq; float* row = Sx + q * SA_SP; const int k_lo = 16 * t_lo, k_hi = 16 * ntile;
        float m = -__builtin_inff();
        for (int k = k_lo + lane; k < k_hi; k += 64) m = fmaxf(m, row[k]);
        m = wave_max(m); float s = 0.f;
        for (int k = k_lo + lane; k < k_hi; k += 64) { const float p = __expf(row[k] - m); row[k] = p; s += p; }
        s = wave_sum(s); if (lane == 0) { Lr[q] = s; Mr[q] = m; } }
    __syncthreads();
    f32x2 o[16];
#pragma unroll
    for (int q = 0; q < 16; ++q) o[q] = (f32x2){0.f, 0.f};
    for (int tile = t_lo + wid; tile < ntile; tile += 8) {
        f32x2 vv[16];
#pragma unroll
        for (int kk = 0; kk < 16; ++kk) { const int key = tile * 16 + kk;
            const float* vp = key < ncache ? cV + (size_t)key * cstride : nV + (size_t)(key - ncache) * nstride;
            vv[kk] = *(const f32x2*)(vp + 2 * lane); }
#pragma unroll
        for (int kk = 0; kk < 16; ++kk) { const int key = tile * 16 + kk;
#pragma unroll
            for (int q = 0; q < 16; ++q) { const float p = Sx[q * SA_SP + key]; o[q] += vv[kk] * p; } }
    }
    __syncthreads();
    float* Pp = Sx;
#pragma unroll
    for (int q = 0; q < 16; ++q) *(f32x2*)(Pp + (wid * 16 + q) * 128 + 2 * lane) = o[q];
    __syncthreads();
    { const int q = tid >> 5, d4 = (tid & 31) * 4; f32x4 s = {0.f, 0.f, 0.f, 0.f};
#pragma unroll
      for (int w = 0; w < 8; ++w) s += *(const f32x4*)(Pp + (w * 16 + q) * 128 + d4);
      if (part) { *(f32x4*)(part + q * 128 + d4) = s; if (d4 == 0) { part[2048 + q] = Mr[q]; part[2064 + q] = Lr[q]; } }
      else { const float rl = 1.f / Lr[q]; s = s * rl;
      u32x2 w2; w2.x = cvt_pk_bf16(s[0], s[1]); w2.y = cvt_pk_bf16(s[2], s[3]);
      *(u32x2*)(Op + (size_t)q * rsq + d4) = w2; } }
    __syncthreads();
}


#define XB_TMO      128
#define XB_XCNT(j)  (256  + 64 * (j))
#define XB_XSUB(j)  (1280 + 64 * (j))
#define XB_XGEN(j)  (2304 + 64 * (j))
#define XB_TOP      3328
#define XB_TOPGEN   3392
#define XCD_BAR_WORDS 3456
#define XB_SPIN_CAP (1u << 22)
__device__ __forceinline__ unsigned xb_ld(unsigned* p)              { return __hip_atomic_load(p, __ATOMIC_RELAXED, __HIP_MEMORY_SCOPE_AGENT); }
__device__ __forceinline__ unsigned xb_add(unsigned* p, unsigned v) { return __hip_atomic_fetch_add(p, v, __ATOMIC_RELAXED, __HIP_MEMORY_SCOPE_AGENT); }
__device__ __forceinline__ unsigned xb_xcc_id() { return (unsigned)__builtin_amdgcn_s_getreg((3 << 11) | 20) & 0xFu; }
#define XB_SPIN(cond, bar) do { unsigned _sp = 0; while (cond) { __builtin_amdgcn_s_sleep(1); \
    if ((++_sp & 255u) == 0u) { if (xb_ld(&(bar)[XB_TMO])) break; if (_sp > XB_SPIN_CAP) { atomicAdd(&(bar)[XB_TMO], 1u); break; } } } } while (0)
struct XcdBarrier { unsigned* bar; unsigned x; volatile LAS unsigned* st; };
__device__ __forceinline__ XcdBarrier xcd_barrier_post(unsigned* bar, volatile LAS unsigned* st) {
    XcdBarrier b; b.bar = bar; b.x = xb_xcc_id(); b.st = st;
    if (threadIdx.x == 0) (void)xb_add(&bar[XB_XCNT(b.x)], 1u);
    return b;
}
__device__ __forceinline__ void xcd_barrier_complete(unsigned* bar, unsigned x, unsigned& nloc, unsigned& nx) {
    const unsigned G = gridDim.x * gridDim.y * gridDim.z;
    unsigned sum, cnt, mine, sp = 0u;
    for (;;) {
        sum = 0u; cnt = 0u; mine = 0u;
#pragma unroll
        for (unsigned j = 0; j < 16; ++j) { const unsigned c = xb_ld(&bar[XB_XCNT(j)]); sum += c; cnt += (c > 0u) ? 1u : 0u; mine = (j == x) ? c : mine; }
        if (sum == G) break;
        __builtin_amdgcn_s_sleep(1);
        if ((++sp & 255u) == 0u) { if (xb_ld(&bar[XB_TMO])) break; if (sp > XB_SPIN_CAP) { atomicAdd(&bar[XB_TMO], 1u); break; } }
    }
    nloc = mine > 0u ? mine : 1u; nx = cnt > 0u ? cnt : 1u;
}
__device__ __forceinline__ void xcd_barrier(const XcdBarrier& b) {
    asm volatile("s_waitcnt vmcnt(0)" ::: "memory");
    __syncthreads();
    if (threadIdx.x == 0) {
        unsigned* bar = b.bar;
        __builtin_amdgcn_s_waitcnt(0);
        unsigned nloc = b.st[0], nx = b.st[1];
        if (nloc == 0u) { xcd_barrier_complete(bar, b.x, nloc, nx); b.st[0] = nloc; b.st[1] = nx; }
        const unsigned old = xb_add(&bar[XB_XSUB(b.x)], 1u);
        const unsigned gen = old / nloc;
        if (old + 1u == (gen + 1u) * nloc) {
            __builtin_amdgcn_fence(__ATOMIC_RELEASE, "agent");
            asm volatile("s_waitcnt vmcnt(0)" ::: "memory");
            const unsigned og = xb_add(&bar[XB_TOP], 1u);
            const unsigned tg = og / nx;
            if (og + 1u == (tg + 1u) * nx) xb_add(&bar[XB_TOPGEN], 1u);
            else XB_SPIN(xb_ld(&bar[XB_TOPGEN]) == tg, bar);
            __builtin_amdgcn_fence(__ATOMIC_ACQUIRE, "agent");
            xb_add(&bar[XB_XGEN(b.x)], 1u);
            asm volatile("s_waitcnt vmcnt(0)" ::: "memory");
        } else {
            XB_SPIN(xb_ld(&bar[XB_XGEN(b.x)]) == gen, bar);
            __builtin_amdgcn_fence(__ATOMIC_ACQUIRE, "agent");
            asm volatile("s_waitcnt vmcnt(0)" ::: "memory");
        }
    }
    __syncthreads();
}


__device__ __forceinline__ unsigned short f2bf_rne(float x) { return (unsigned short)(cvt_pk_bf16(x, 0.f) & 0xffffu); }
template <class BRow, class EpiFn>
__device__ __forceinline__ void sgemm(char* lds, const bf16_t* A, int lda, int K, int ncg, int vcu, int G, const bf16_t* Bt, int ldb, BRow brow, EpiFn epi) {
    const int tid = threadIdx.x, lane = tid & 63, wave = __builtin_amdgcn_readfirstlane(tid >> 6), fr = lane & 15, fq = lane >> 4;
    asm volatile("" : "+s"(K));
    const int nst = K / 256;
    f32x4* red = (f32x4*)lds;
    for (int job = vcu; job < ncg * 4; job += G) {
        const int rg = job & 3, cg = job >> 2;
        const bf16_t* ap = A + (size_t)(32 * rg + fr) * lda + fq * 8 + wave * 32;
        const bf16_t* bp0 = Bt + (size_t)brow(cg, 0, fr) * ldb + fq * 8 + wave * 32;
        const bf16_t* bp1 = Bt + (size_t)brow(cg, 1, fr) * ldb + fq * 8 + wave * 32;
        const size_t a16 = (size_t)16 * lda;
        f32x4 acc[2][2];
#pragma unroll
        for (int i = 0; i < 2; ++i)
#pragma unroll
            for (int j = 0; j < 2; ++j) acc[i][j] = (f32x4){0.f, 0.f, 0.f, 0.f};
        bf16x8 x0[4], x1[4];
#define SG_LOAD(x, st) do { const int ko_ = (st) * 256; x[0] = *(const bf16x8*)(ap + ko_); x[1] = *(const bf16x8*)(ap + a16 + ko_); x[2] = *(const bf16x8*)(bp0 + ko_); x[3] = *(const bf16x8*)(bp1 + ko_); } while (0)
#define SG_MMA(x) do { acc[0][0] = __builtin_amdgcn_mfma_f32_16x16x32_bf16(x[0], x[2], acc[0][0], 0, 0, 0); acc[0][1] = __builtin_amdgcn_mfma_f32_16x16x32_bf16(x[0], x[3], acc[0][1], 0, 0, 0); \
                         acc[1][0] = __builtin_amdgcn_mfma_f32_16x16x32_bf16(x[1], x[2], acc[1][0], 0, 0, 0); acc[1][1] = __builtin_amdgcn_mfma_f32_16x16x32_bf16(x[1], x[3], acc[1][1], 0, 0, 0); } while (0)
        bf16x8 y0[4], y1[4];
        SG_LOAD(x0, 0); SG_LOAD(x1, 1);
#pragma unroll 1
        for (int st = 0; st < nst; st += 4) {
            if (st + 2 < nst) { SG_LOAD(y0, st + 2); SG_LOAD(y1, st + 3); }
            SG_MMA(x0); SG_MMA(x1);
            if (st + 4 < nst) { SG_LOAD(x0, st + 4); SG_LOAD(x1, st + 5); }
            if (st + 2 < nst) { SG_MMA(y0); SG_MMA(y1); }
        }
#undef SG_LOAD
#undef SG_MMA
#pragma unroll
        for (int i = 0; i < 2; ++i)
#pragma unroll
            for (int j = 0; j < 2; ++j) red[(wave * 4 + i * 2 + j) * 64 + lane] = acc[i][j];
        __syncthreads();
        if (wave < 4) { f32x4 sum = red[wave * 64 + lane];
#pragma unroll
            for (int w = 1; w < 8; ++w) sum += red[(w * 4 + wave) * 64 + lane];
            epi(cg, wave & 1, 32 * rg + 16 * (wave >> 1) + 4 * fq, fr, lane, sum); }
        __syncthreads();
    }
}
__device__ __forceinline__ void sgemm_res(char* lds, const bf16_t* A, int lda, int K, int vcu, int G, const bf16_t* Bt, int ldb, bf16_t* XB, float* ss_out) {
    sgemm(lds, A, lda, K, DM / 32, vcu, G, Bt, ldb, [](int cg, int j, int fr) { return 32 * cg + 16 * j + fr; },
          [=](int cg, int j, int r0, int fr, int lane, f32x4 acc) {
#pragma unroll
              for (int r = 0; r < 4; ++r) { const int row = MP + r0 + r; bf16_t* px = XB + (size_t)row * DM + 32 * cg + 16 * j + fr;
                  const float x = bf2f(*px) + acc[r]; *px = f2bf_rne(x); float sq = x * x;
                  sq += __shfl_xor(sq, 1); sq += __shfl_xor(sq, 2); sq += __shfl_xor(sq, 4); sq += __shfl_xor(sq, 8);
                  if (fr == 0) __hip_atomic_fetch_add(ss_out + row, sq, __ATOMIC_RELAXED, __HIP_MEMORY_SCOPE_AGENT); } });
}

__device__ __forceinline__ float lru_step(float h, float la, float g) {
    const float a = __expf(la), e = 2.f * la;
    const float ser = -e * (1.f + e * (0.5f + e * (0.16666667f + e * 0.041666668f)));
    const float om = e > -0.125f ? ser : 1.f - a * a;
    return a * h + __builtin_amdgcn_sqrtf(fmaxf(om, 0.f)) * g;
}

template <int MAP> __device__ __forceinline__ int rowmap(int n) {
    if (MAP == 1) { const int up = n >= DFF ? 1 : 0; const int c = up ? n - DFF : n; return (c >> 7) * 256 + up * 128 + (c & 127); }
    if (MAP == 2) return (n >> 7) * 256 + (n & 127);
    if (MAP == 3) return (n >> 7) * 256 + 128 + (n & 127);
    return n;
}
template <int MAP> __device__ __forceinline__ void tr_item(const float* W, int ldw, int nvalid, const float* gain, bf16_t* WT, int ldwt, int nblk, LAS float* scr, int item, int lane) {
    const int kb = item / nblk, nb = item % nblk, k0 = 64 * kb, n0 = 32 * nb;
    const int n = n0 + (lane & 31);
    float tv[32];
#pragma unroll
    for (int i = 0; i < 32; ++i) { const int kk = 2 * i + (lane >> 5); tv[i] = (n < nvalid) ? __builtin_nontemporal_load(&W[(size_t)(k0 + kk) * ldw + n]) : 0.f; }
    if (gain) {
#pragma unroll
        for (int i = 0; i < 32; ++i) tv[i] *= gain[k0 + 2 * i + (lane >> 5)]; }
#pragma unroll
    for (int i = 0; i < 32; ++i) scr[(2 * i + (lane >> 5)) * 33 + (lane & 31)] = tv[i];
    LDS_WAIT(); asm volatile("" ::: "memory");
    const int c = lane & 7; const int r0 = rowmap<MAP>(n0);
#pragma unroll
    for (int j = 0; j < 4; ++j) { const int nn = (lane >> 3) + 8 * j; const LAS float* s = scr + (8 * c) * 33 + nn;
        u32x4 o; o.x = cvt_pk_bf16(s[0 * 33], s[1 * 33]); o.y = cvt_pk_bf16(s[2 * 33], s[3 * 33]); o.z = cvt_pk_bf16(s[4 * 33], s[5 * 33]); o.w = cvt_pk_bf16(s[6 * 33], s[7 * 33]);
        *(u32x4*)(WT + (size_t)(r0 + nn) * ldwt + k0 + 8 * c) = o; }
    LDS_WAIT(); asm volatile("" ::: "memory");
}

struct Args { const float* in[32]; float* out; unsigned char* ws; int ph_lo, ph_hi; };

__device__ __forceinline__ att::BlockRef fox_ref(int vcu, int G, int idx, bf16_t* Qb, bf16_t* Kb, bf16_t* Vb, bf16_t* Ob, const float* biasP, float* fout) {
    const int k = idx >> 1, pass = idx & 1, L = vcu + k * G, bh = L >> 3, x = L & 7, qb = pass ? 15 - x : x, b = bh >> 4, h = bh & 15;
    att::BlockRef r;
    r.Q = (const att::bf16*)(Qb + ((size_t)(b * SEQ + qb * 256)) * DM + h * HD); r.O = (att::bf16*)(Ob + ((size_t)(b * SEQ + qb * 256)) * DM + h * HD);
    r.K = (const att::bf16*)(Kb + (size_t)b * SEQ * DM + h * HD); r.V = (const att::bf16*)(Vb + (size_t)b * SEQ * DM + h * HD);
    r.cb = biasP + (size_t)bh * SEQ; r.fk = fout + O_PK + (size_t)b * SEQ * DM + h * HD; r.fv = fout + O_PV + (size_t)b * SEQ * DM + h * HD; r.P0 = qb * 256; return r;
}
__device__ __forceinline__ att::BlockRef xat_ref(int vcu, int G, int idx, bf16_t* Q2, const bf16_t* MK, const bf16_t* MVv, int layer) {
    const int L = vcu + idx * G, pm = L >> 2, h = L & 3, b = pm >> 4;
    att::BlockRef r;
    r.Q = (const att::bf16*)(Q2 + (size_t)pm * 256 * MEMW + h * HD); r.O = (att::bf16*)(Q2 + (size_t)pm * 256 * MEMW + h * HD);
    r.K = (const att::bf16*)(MK + ((size_t)(layer * 2048 + b * 256)) * MEMW + h * HD); r.V = (const att::bf16*)(MVv + ((size_t)(layer * 2048 + b * 256)) * MEMW + h * HD);
    r.cb = nullptr; r.fk = nullptr; r.fv = nullptr; r.P0 = 256; return r;
}

__global__ void __launch_bounds__(512, 2) mk_fwd(Args a) {
    extern __shared__ __attribute__((aligned(16))) unsigned char lds[];
    cg::grid_group grid = cg::this_grid();
    const int tid = threadIdx.x, lane = tid & 63, wave = __builtin_amdgcn_readfirstlane(tid >> 6);
    const int G = gridDim.x, bx = blockIdx.x; const int vcu = (G % 8 == 0) ? (bx % 8) * (G / 8) + bx / 8 : bx;
    const int gw = vcu * 8 + wave, NGW = G * 8, gt = vcu * 512 + tid, GT = G * 512;
    unsigned char* ws = a.ws; float* out = a.out;
    bf16_t* WFIN = (bf16_t*)(ws + WS_WFIN); bf16_t* WFOUT = (bf16_t*)(ws + WS_WFOUT); bf16_t* WLIN = (bf16_t*)(ws + WS_WLIN); bf16_t* WGATE = (bf16_t*)(ws + WS_WGATE);
    bf16_t* WLOUT = (bf16_t*)(ws + WS_WLOUT); bf16_t* WXQ = (bf16_t*)(ws + WS_WXQ); bf16_t* WXKV = (bf16_t*)(ws + WS_WXKV); bf16_t* WXO = (bf16_t*)(ws + WS_WXO);
    bf16_t* WFFI = (bf16_t*)(ws + WS_WFFI); bf16_t* WFFO = (bf16_t*)(ws + WS_WFFO);
    bf16_t* XB = (bf16_t*)(ws + WS_XB); bf16_t* Qb = (bf16_t*)(ws + WS_BIG); bf16_t* Kb = (bf16_t*)(ws + WS_BIG + ACT_B); bf16_t* Vb = (bf16_t*)(ws + WS_BIG + 2 * ACT_B); bf16_t* X4 = (bf16_t*)(ws + WS_BIG + 3 * ACT_B);
    bf16_t* Hb = Qb; bf16_t* Gb = Qb; bf16_t* Ub = Kb; bf16_t* LAb = Kb; bf16_t* UCb = Vb; bf16_t* BBb = X4;
    bf16_t* Q2 = (bf16_t*)(ws + WS_Q2); bf16_t* MEMN = (bf16_t*)(ws + WS_MEMN); bf16_t* MEMK = (bf16_t*)(ws + WS_MEMK); bf16_t* MEMV = (bf16_t*)(ws + WS_MEMV);
    float* SS = (float*)(ws + WS_SS); float* biasP = (float*)(ws + WS_BIASP); float* biasS = (float*)(ws + WS_BIASS);
    float* CA = (float*)(ws + WS_CA); float* CBv = (float*)(ws + WS_CB); float* SPL = (float*)(ws + WS_SPL);
    PG8_LAS unsigned char* lds3 = (PG8_LAS unsigned char*)lds;
    const int lo = a.ph_lo, hi = a.ph_hi;
#ifndef SKIPMASK
#define SKIPMASK 0u
#endif
#define IN(k) (lo <= (k) && (k) < hi && !((SKIPMASK >> (k)) & 1u))
    unsigned* barw = (unsigned*)(ws + WS_BAR);
    volatile LAS unsigned* bst = (volatile LAS unsigned*)(lds3 + 143360);
    if (tid < 2) bst[tid] = 0u;
    __syncthreads();
    XcdBarrier xbar; xbar.bar = barw; xbar.x = 0; xbar.st = bst;
    if (hi - lo > 1) xbar = xcd_barrier_post(barw, bst);
    if (lo < 0) grid.sync();
#define SEAM(k) do { if (IN(k) && IN((k) + 1)) xcd_barrier(xbar); } while (0)
    constexpr int NOB = 1 << 30;

    if (IN(0)) {
        for (int i = gt; i < 6 * MR; i += GT) SS[MR + i] = 0.f;
        for (int i = gt; i < DM; i += GT) { const float x = -a.in[25][i]; SPL[i] = 8.f * (fmaxf(x, 0.f) + log1pf(__expf(-fabsf(x)))); }
        for (int r = gw; r < MR; r += NGW) {
            u32x2* o8 = (u32x2*)(XB + (size_t)r * DM) + lane;
            if (r < MV) { const float* src = r < MP ? a.in[0] + (size_t)r * DM : a.in[1] + (size_t)(r - MP) * DM; const f32x4* xr = (const f32x4*)src + lane;
                f32x4 v[8]; float s = 0.f;
#pragma unroll
                for (int j = 0; j < 8; ++j) { v[j] = __builtin_nontemporal_load(&xr[64 * j]); s += (v[j][0] * v[j][0] + v[j][1] * v[j][1]) + (v[j][2] * v[j][2] + v[j][3] * v[j][3]); }
                s = wave_sum(s); if (lane == 0) SS[r] = s;
#pragma unroll
                for (int j = 0; j < 8; ++j) { u32x2 w; w.x = cvt_pk_bf16(v[j][0], v[j][1]); w.y = cvt_pk_bf16(v[j][2], v[j][3]); o8[64 * j] = w; }
            } else {
#pragma unroll
                for (int j = 0; j < 8; ++j) o8[64 * j] = (u32x2){0u, 0u};
                if (lane == 0) SS[r] = 0.f;
            }
        }
        for (int r = gw; r < 4096; r += NGW) { const int layer = r >> 11, row = r & 2047;
            const f32x4* xr = (const f32x4*)(a.in[2] + (size_t)row * DM) + lane; const f32x4* gr = (const f32x4*)(a.in[11] + (size_t)layer * DM) + lane;
            f32x4 v[8]; float s = 0.f;
#pragma unroll
            for (int j = 0; j < 8; ++j) { v[j] = xr[64 * j]; s += (v[j][0] * v[j][0] + v[j][1] * v[j][1]) + (v[j][2] * v[j][2] + v[j][3] * v[j][3]); }
            const float rs = __builtin_amdgcn_rsqf(wave_sum(s) * (1.f / DM) + EPS);
            u32x2* o8 = (u32x2*)(MEMN + (size_t)r * DM) + lane;
#pragma unroll
            for (int j = 0; j < 8; ++j) { const f32x4 g4 = gr[64 * j]; u32x2 w; w.x = cvt_pk_bf16(v[j][0] * rs * g4[0], v[j][1] * rs * g4[1]); w.y = cvt_pk_bf16(v[j][2] * rs * g4[2], v[j][3] * rs * g4[3]); o8[64 * j] = w; }
        }
        LAS float* scr = (LAS float*)(lds3) + wave * (64 * 33 + 16);
        int base = 0;
#define TR_JOB(MAP, W, ldw, nvalid, gain, WT, ldwt, K, Npad) do { const int nblk_ = (Npad) / 32, nit_ = ((K) / 64) * nblk_; int st_ = (gw - base) % NGW; if (st_ < 0) st_ += NGW; \
        for (int it_ = st_; it_ < nit_; it_ += NGW) tr_item<MAP>(W, ldw, nvalid, gain, WT, ldwt, nblk_, scr, it_, lane); base = (base + nit_) % NGW; } while (0)
        TR_JOB(0, a.in[15], NFIN, NFIN, a.in[10], WFIN, DM, DM, NFIN_PAD);
        TR_JOB(0, a.in[17], DM, DM, (const float*)nullptr, WFOUT, DM, DM, DM);
        TR_JOB(0, a.in[18], 2 * DM, 2 * DM, a.in[10] + DM, WLIN, DM, DM, 2 * DM);
        for (int blk = 0; blk < 8; ++blk) {
            TR_JOB(2, a.in[21] + (size_t)blk * 65536, 256, 256, (const float*)nullptr, WGATE + (size_t)blk * 2 * 65536, 256, 256, 256);
            TR_JOB(3, a.in[23] + (size_t)blk * 65536, 256, 256, (const float*)nullptr, WGATE + (size_t)blk * 2 * 65536, 256, 256, 256);
        }
        TR_JOB(0, a.in[26], DM, DM, (const float*)nullptr, WLOUT, DM, DM, DM);
        for (int i = 0; i < 2; ++i) {
            TR_JOB(0, a.in[27] + (size_t)i * DM * MEMW, MEMW, MEMW, a.in[12] + (size_t)i * DM, WXQ + (size_t)i * MEMW * DM, DM, DM, MEMW);
            TR_JOB(0, a.in[28] + (size_t)i * DM * 2 * MEMW, 2 * MEMW, 2 * MEMW, (const float*)nullptr, WXKV + (size_t)i * 2 * MEMW * DM, DM, DM, 2 * MEMW);
            TR_JOB(0, a.in[29] + (size_t)i * MEMW * DM, DM, DM, (const float*)nullptr, WXO + (size_t)i * DM * MEMW, MEMW, MEMW, DM);
            TR_JOB(1, a.in[30] + (size_t)i * DM * 2 * DFF, 2 * DFF, 2 * DFF, a.in[13] + (size_t)i * DM, WFFI + (size_t)i * 2 * DFF * DM, DM, DM, 2 * DFF);
            TR_JOB(0, a.in[31] + (size_t)i * DFF * DM, DM, DM, (const float*)nullptr, WFFO + (size_t)i * DM * DFF, DFF, DFF, DM);
        }
#undef TR_JOB
        __syncthreads();
    }
    SEAM(0);

    if (IN(1)) {
        { pg8::Gemm g{XB, WFIN, DM, DM, DM, 0, NOB, 0, 128}; pg8::StaticOrder S; S.init(NTM, 25, G, bx);
          pg8::EpiFoxIn E{SS, Qb, Kb, Vb, out, a.in[16]}; pg8::gemm_phase(lds3, g, S, E); }
        { pg8::Gemm g{MEMN, WXKV, DM, DM, DM, 0, 8, 2 * MEMW, -1}; pg8::StaticOrder S; S.init(16, 4, G, G - 1 - bx);
          pg8::EpiMemKV E{out, MEMK, MEMV}; pg8::gemm_phase(lds3, g, S, E); }
    }
    SEAM(1);

    if (IN(2)) {
        float* PART = (float*)(ws + WS_BIASS);
        for (int u = vcu; u < 256; u += G) {
            { const int bh = u >> 1, half = u & 1, b = bh >> 4, h = bh & 15;
                small_attn((char*)lds, Qb + (size_t)(MP + b * DSQ) * DM + h * HD, DM, a.in[3] + ((size_t)b * PAST * NH + h) * HD, a.in[4] + ((size_t)b * PAST * NH + h) * HD, NH * HD, PAST,
                           out + O_SK + (size_t)(b * DSQ) * DM + h * HD, out + O_SV + (size_t)(b * DSQ) * DM + h * HD, DM, DSQ,
                           a.in[5] + (size_t)b * PAST * NH + h, out + O_SLF + (size_t)(b * DSQ) * NH + h, (bf16_t*)nullptr, half ? 65 : 0, half ? 129 : 65, PART + (size_t)u * BIASS_LD); }
            if (u & 1) { const int q = u >> 1, b = q >> 4, h = q & 15;
                const float* lf = out + O_PLF + (size_t)b * SEQ * NH + h; float* Wt = (float*)lds; float l8[8]; float sm = 0.f;
#pragma unroll
                for (int i = 0; i < 8; ++i) { l8[i] = lf[(size_t)(8 * tid + i) * NH]; sm += l8[i]; }
                float inc = sm;
#pragma unroll
                for (int o = 1; o < 64; o <<= 1) { const float t = __shfl_up(inc, o); if (lane >= o) inc += t; }
                if (lane == 63) Wt[wave] = inc;
                __syncthreads();
                float c = inc - sm;
                for (int w = 0; w < wave; ++w) c += Wt[w];
                float* bp = biasP + (size_t)q * SEQ + 8 * tid; f32x4 o0, o1;
#pragma unroll
                for (int i = 0; i < 4; ++i) { c += l8[i]; o0[i] = -c * INV_SCALE; }
#pragma unroll
                for (int i = 0; i < 4; ++i) { c += l8[4 + i]; o1[i] = -c * INV_SCALE; }
                *(f32x4*)bp = o0; *(f32x4*)(bp + 4) = o1;
                __syncthreads();
            }
        }
    }
    SEAM(2);

    if (IN(3)) {
        for (int u = vcu; u < 128; u += G) { const int b = u >> 4, h = u & 15, q = tid >> 5, d4 = (tid & 31) * 4;
            const float* p0 = (const float*)(ws + WS_BIASS) + (size_t)(2 * u) * BIASS_LD; const float* p1 = p0 + BIASS_LD;
            const float m0 = p0[2048 + q], m1 = p1[2048 + q], m = fmaxf(m0, m1), w0 = __expf(m0 - m), w1 = __expf(m1 - m);
            const float rl = 1.f / (p0[2064 + q] * w0 + p1[2064 + q] * w1);
            const f32x4 v = (*(const f32x4*)(p0 + q * 128 + d4) * w0 + *(const f32x4*)(p1 + q * 128 + d4) * w1) * rl;
            u32x2 w2; w2.x = cvt_pk_bf16(v[0], v[1]); w2.y = cvt_pk_bf16(v[2], v[3]);
            *(u32x2*)(X4 + (size_t)(MP + b * DSQ + q) * DM + h * HD + d4) = w2; }
        const int nitems = vcu < 1024 ? (1024 - vcu + G - 1) / G : 0, nblk = 2 * nitems;
        if (nblk > 0) { att::Seam S; att::BlockRef cur = fox_ref(vcu, G, 0, Qb, Kb, Vb, X4, biasP, out);
            att::att_prime<DM, DM, true>(cur, NOB, (char*)lds, S);
            for (int i = 0; i < nblk; ++i) { const att::BlockRef nxt = (i + 1 < nblk) ? fox_ref(vcu, G, i + 1, Qb, Kb, Vb, X4, biasP, out) : cur;
                if ((i & 1) == 0) { for (int k = tid * 4; k < SEQ; k += 2048) *(f32x4*)(lds + att::LDS_BIAS + k * 4) = *(const f32x4*)(cur.cb + k); __syncthreads(); }
                att::att_block<DM, DM, true>(cur, nxt, SEQ, NOB, (char*)lds, S); cur = nxt; } }
    }
    SEAM(3);

    if (IN(4)) { pg8::Gemm g{X4, WFOUT, DM, DM, DM, 0, NOB, 0, 128}; pg8::StaticOrder S; S.init(128, 8, G, bx);
        pg8::EpiRes E{XB, SS + 1 * MR}; pg8::gemm_phase(lds3, g, S, E);
        sgemm_res((char*)lds, X4 + (size_t)MP * DM, DM, DM, vcu, G, WFOUT, DM, XB, SS + 1 * MR); }
    SEAM(4);

#define XATTN_FFN(i, pb, ssA, ssB, ssC) do { \
    if (IN(pb)) { pg8::Gemm g{XB, WXQ + (size_t)(i) * MEMW * DM, DM, DM, DM, 0, NOB, 0, 128}; pg8::StaticOrder S; S.init(128, 2, G, bx); \
        pg8::EpiScale E{SS + (ssA) * MR, Q2, MEMW}; pg8::gemm_phase(lds3, g, S, E); \
        { const float* ssp = SS + (ssA) * MR; bf16_t* q2 = Q2; \
          sgemm((char*)lds, XB + (size_t)MP * DM, DM, DM, MEMW / 32, G - 1 - vcu, G, WXQ + (size_t)(i) * MEMW * DM, DM, [](int cg, int j, int fr) { return 32 * cg + 16 * j + fr; }, \
              [=](int cg, int j, int r0, int fr, int lane, f32x4 acc) { _Pragma("unroll") for (int r = 0; r < 4; ++r) { const int row = MP + r0 + r; \
                  q2[(size_t)row * MEMW + 32 * cg + 16 * j + fr] = f2bf_rne(acc[r] * pg8::rstd_of(ssp, row)); } }); } } \
    SEAM(pb); \
    if (IN((pb) + 1)) { \
        for (int u = G - 1 - vcu; u < 32; u += G) { const int b = u >> 2, h = u & 3; bf16_t* qp = Q2 + (size_t)(MP + b * DSQ) * MEMW + h * HD; \
            small_attn((char*)lds, qp, MEMW, a.in[6] + (((size_t)((i) * NB + b) * NMEM) * 4 + h) * HD, a.in[7] + (((size_t)((i) * NB + b) * NMEM) * 4 + h) * HD, MEMW, NMEM, \
                       (const float*)nullptr, (const float*)nullptr, 0, 0, (const float*)nullptr, (const float*)nullptr, qp); } \
        const int nblk = vcu < 512 ? (512 - vcu + G - 1) / G : 0; \
        if (nblk > 0) { att::Seam S; att::BlockRef cur = xat_ref(vcu, G, 0, Q2, MEMK, MEMV, (i)); \
            att::att_prime<MEMW, MEMW, false>(cur, NOB, (char*)lds, S); \
            for (int k = 0; k < nblk; ++k) { const att::BlockRef nxt = (k + 1 < nblk) ? xat_ref(vcu, G, k + 1, Q2, MEMK, MEMV, (i)) : cur; \
                att::att_block<MEMW, MEMW, false>(cur, nxt, NMEM, NOB, (char*)lds, S); cur = nxt; } } } \
    SEAM((pb) + 1); \
    if (IN((pb) + 2)) { pg8::Gemm g{Q2, WXO + (size_t)(i) * DM * MEMW, MEMW, MEMW, MEMW, 0, NOB, 0, 128}; pg8::StaticOrder S; S.init(128, 8, G, bx); \
        pg8::EpiRes E{XB, SS + (ssB) * MR}; pg8::gemm_phase(lds3, g, S, E); \
        sgemm_res((char*)lds, Q2 + (size_t)MP * MEMW, MEMW, MEMW, vcu, G, WXO + (size_t)(i) * DM * MEMW, MEMW, XB, SS + (ssB) * MR); } \
    SEAM((pb) + 2); \
    if (IN((pb) + 3)) { pg8::Gemm g{XB, WFFI + (size_t)(i) * 2 * DFF * DM, DM, DM, DM, 0, NOB, 0, 128}; pg8::StaticOrder S; S.init(NTM, 44, G, bx); \
        pg8::EpiSwiglu E{SS + (ssB) * MR, Hb}; pg8::gemm_phase(lds3, g, S, E); } \
    SEAM((pb) + 3); \
    if (IN((pb) + 4)) { pg8::Gemm g{Hb, WFFO + (size_t)(i) * DM * DFF, DFF, DFF, DFF, 0, NOB, 0, 128}; pg8::StaticOrder S; S.init(128, 8, G, bx); \
        pg8::EpiRes E{XB, SS + (ssC) * MR}; pg8::gemm_phase(lds3, g, S, E); \
        sgemm_res((char*)lds, Hb + (size_t)MP * DFF, DFF, DFF, vcu, G, WFFO + (size_t)(i) * DM * DFF, DFF, XB, SS + (ssC) * MR); } \
    SEAM((pb) + 4); } while (0)

    XATTN_FFN(0, 5, 1, 2, 3);

    if (IN(10)) { pg8::Gemm g{XB, WLIN, DM, DM, DM, 0, NOB, 0, 128}; pg8::StaticOrder S; S.init(128, 16, G, bx);
        pg8::EpiLruIn E{SS + 3 * MR, Gb, Ub, out}; pg8::gemm_phase(lds3, g, S, E);
        { const float* ssp = SS + 3 * MR; bf16_t* gb = Gb; bf16_t* ub = Ub; float* o = out;
          sgemm((char*)lds, XB + (size_t)MP * DM, DM, DM, 2 * DM / 32, vcu, G, WLIN, DM, [](int cg, int j, int fr) { return 32 * cg + 16 * j + fr; },
              [=](int cg, int j, int r0, int fr, int lane, f32x4 acc) {
#pragma unroll
                  for (int r = 0; r < 4; ++r) { const int rl = r0 + r, row = MP + rl; const float v = acc[r] * pg8::rstd_of(ssp, row); const int col = 32 * cg + 16 * j + fr;
                      if (col < DM) gb[(size_t)row * DM + col] = f2bf_rne(gelu_tanh_(v));
                      else { ub[(size_t)row * DM + col - DM] = f2bf_rne(v); const int tt = rl & 15; if (tt >= 13) o[O_SLC + ((size_t)(rl >> 4) * 3 + (tt - 13)) * DM + col - DM] = v; } } }); } }
    SEAM(10);

    if (IN(11)) {
        const float* cw = a.in[19]; const float* cbias = a.in[20];
        for (int it = gt; it < (MV / 16) * 256; it += GT) { const int cgp = it & 255, run = it >> 8, row0 = run * 16, ch = cgp * 8;
            float w0[8], w1[8], w2[8], k0[8], k1[8], k2[8], k3[8], cb8[8];
#pragma unroll
            for (int j = 0; j < 8; ++j) { k0[j] = cw[ch + j]; k1[j] = cw[DM + ch + j]; k2[j] = cw[2 * DM + ch + j]; k3[j] = cw[3 * DM + ch + j]; cb8[j] = cbias[ch + j]; w0[j] = 0.f; w1[j] = 0.f; w2[j] = 0.f; }
            if (row0 >= MP) { const float* st = a.in[9] + (size_t)((row0 - MP) >> 4) * 3 * DM + ch;
#pragma unroll
                for (int j = 0; j < 8; ++j) { w0[j] = st[j]; w1[j] = st[DM + j]; w2[j] = st[2 * DM + j]; }
            } else if ((row0 & (SEQ - 1)) != 0) {
                const u32x4 a0 = *(const u32x4*)(Ub + (size_t)(row0 - 3) * DM + ch), a1 = *(const u32x4*)(Ub + (size_t)(row0 - 2) * DM + ch), a2 = *(const u32x4*)(Ub + (size_t)(row0 - 1) * DM + ch);
#pragma unroll
                for (int j = 0; j < 4; ++j) { w0[2 * j] = bflo(a0[j]); w0[2 * j + 1] = bfhi(a0[j]); w1[2 * j] = bflo(a1[j]); w1[2 * j + 1] = bfhi(a1[j]); w2[2 * j] = bflo(a2[j]); w2[2 * j + 1] = bfhi(a2[j]); }
            }
#pragma unroll 8
            for (int t = 0; t < 16; ++t) { const u32x4 cu = *(const u32x4*)(Ub + (size_t)(row0 + t) * DM + ch); float c8[8], o8[8];
#pragma unroll
                for (int j = 0; j < 4; ++j) { c8[2 * j] = bflo(cu[j]); c8[2 * j + 1] = bfhi(cu[j]); }
#pragma unroll
                for (int j = 0; j < 8; ++j) { o8[j] = cb8[j] + w0[j] * k0[j] + w1[j] * k1[j] + w2[j] * k2[j] + c8[j] * k3[j]; w0[j] = w1[j]; w1[j] = w2[j]; w2[j] = c8[j]; }
                u32x4 w; w.x = cvt_pk_bf16(o8[0], o8[1]); w.y = cvt_pk_bf16(o8[2], o8[3]); w.z = cvt_pk_bf16(o8[4], o8[5]); w.w = cvt_pk_bf16(o8[6], o8[7]);
                *(u32x4*)(UCb + (size_t)(row0 + t) * DM + ch) = w; }
        }
    }
    SEAM(11);

    if (IN(12)) { pg8::Gemm g{UCb, WGATE, DM, 256, 256, 256, NOB, 0, 128}; pg8::StaticOrder S; S.init(NTM, 16, G, bx);
        pg8::EpiGates E{UCb, a.in[22], a.in[24], SPL, LAb, BBb}; pg8::gemm_phase(lds3, g, S, E); }
    SEAM(12);

#define LOAD8(dst, p) do { const u32x4 w_ = *(const u32x4*)(p); _Pragma("unroll") for (int j_ = 0; j_ < 4; ++j_) { dst[2 * j_] = bflo(w_[j_]); dst[2 * j_ + 1] = bfhi(w_[j_]); } } while (0)
    if (IN(13)) {
        for (int it = gt; it < NB * 64 * 256; it += GT) { const int cgp = it & 255, c = (it >> 8) & 63, b = it >> 14, ch = cgp * 8; const size_t row0 = (size_t)b * SEQ + c * 64;
            float As[8], h[8];
#pragma unroll
            for (int j = 0; j < 8; ++j) { As[j] = 0.f; h[j] = 0.f; }
#pragma unroll 8
            for (int t = 0; t < 64; ++t) { float la[8], bb[8]; LOAD8(la, LAb + (row0 + t) * DM + ch); LOAD8(bb, BBb + (row0 + t) * DM + ch);
#pragma unroll
                for (int j = 0; j < 8; ++j) { h[j] = lru_step(h[j], la[j], bb[j]); As[j] += la[j]; } }
            float* pa = CA + ((size_t)(b * 64 + c)) * DM + ch; float* pb = CBv + ((size_t)(b * 64 + c)) * DM + ch;
#pragma unroll
            for (int j = 0; j < 8; ++j) { pa[j] = __expf(As[j]); pb[j] = h[j]; }
        }
        for (int it = gt; it < NB * 256; it += GT) { const int cgp = it & 255, b = it >> 8, ch = cgp * 8; const size_t row0 = (size_t)MP + b * DSQ;
            float h[8];
#pragma unroll
            for (int j = 0; j < 8; ++j) h[j] = a.in[8][(size_t)b * DM + ch + j];
            for (int t = 0; t < DSQ; ++t) { float la[8], bb[8], gg[8], y[8]; LOAD8(la, LAb + (row0 + t) * DM + ch); LOAD8(bb, BBb + (row0 + t) * DM + ch); LOAD8(gg, Gb + (row0 + t) * DM + ch);
#pragma unroll
                for (int j = 0; j < 8; ++j) { h[j] = lru_step(h[j], la[j], bb[j]); y[j] = h[j] * gg[j]; }
                u32x4 w; w.x = cvt_pk_bf16(y[0], y[1]); w.y = cvt_pk_bf16(y[2], y[3]); w.z = cvt_pk_bf16(y[4], y[5]); w.w = cvt_pk_bf16(y[6], y[7]);
                *(u32x4*)(Gb + (row0 + t) * DM + ch) = w; }
#pragma unroll
            for (int j = 0; j < 8; ++j) out[O_SLH + (size_t)b * DM + ch + j] = h[j];
        }
    }
    SEAM(13);
    if (IN(14)) {
        for (int it = gt; it < NB * DM; it += GT) { const int b = it >> 11, ch = it & (DM - 1); float h = 0.f;
            for (int c0 = 0; c0 < 64; c0 += 16) { float A[16], B[16];
#pragma unroll
                for (int k = 0; k < 16; ++k) { const size_t o = ((size_t)(b * 64 + c0 + k)) * DM + ch; A[k] = CA[o]; B[k] = CBv[o]; }
#pragma unroll
                for (int k = 0; k < 16; ++k) { const size_t o = ((size_t)(b * 64 + c0 + k)) * DM + ch; CBv[o] = h; h = A[k] * h + B[k]; } } }
    }
    SEAM(14);
    if (IN(15)) {
        for (int it = gt; it < NB * 64 * 256; it += GT) { const int cgp = it & 255, c = (it >> 8) & 63, b = it >> 14, ch = cgp * 8; const size_t row0 = (size_t)b * SEQ + c * 64;
            float h[8]; const float* pb = CBv + ((size_t)(b * 64 + c)) * DM + ch;
#pragma unroll
            for (int j = 0; j < 8; ++j) h[j] = pb[j];
#pragma unroll 8
            for (int t = 0; t < 64; ++t) { float la[8], bb[8], gg[8], y[8]; LOAD8(la, LAb + (row0 + t) * DM + ch); LOAD8(bb, BBb + (row0 + t) * DM + ch); LOAD8(gg, Gb + (row0 + t) * DM + ch);
#pragma unroll
                for (int j = 0; j < 8; ++j) { h[j] = lru_step(h[j], la[j], bb[j]); y[j] = h[j] * gg[j]; }
                u32x4 w; w.x = cvt_pk_bf16(y[0], y[1]); w.y = cvt_pk_bf16(y[2], y[3]); w.z = cvt_pk_bf16(y[4], y[5]); w.w = cvt_pk_bf16(y[6], y[7]);
                *(u32x4*)(Gb + (row0 + t) * DM + ch) = w; }
            if (c == 63) {
#pragma unroll
                for (int j = 0; j < 8; ++j) out[O_PLH + (size_t)b * DM + ch + j] = h[j]; }
        }
    }
    SEAM(15);
#undef LOAD8

    if (IN(16)) { pg8::Gemm g{Gb, WLOUT, DM, DM, DM, 0, NOB, 0, 128}; pg8::StaticOrder S; S.init(128, 8, G, bx);
        pg8::EpiRes E{XB, SS + 4 * MR}; pg8::gemm_phase(lds3, g, S, E);
        sgemm_res((char*)lds, Gb + (size_t)MP * DM, DM, DM, vcu, G, WLOUT, DM, XB, SS + 4 * MR); }
    SEAM(16);

    XATTN_FFN(1, 17, 4, 5, 6);

    if (IN(22)) {
        const float* ss6 = SS + 6 * MR;
        for (int r0 = gw; r0 < MV; r0 += 2 * NGW) {
            u32x2 w[2][8];
#pragma unroll
            for (int q = 0; q < 2; ++q) { const int r = (r0 + q * NGW < MV) ? r0 + q * NGW : r0; const u32x2* xr = (const u32x2*)(XB + (size_t)r * DM) + lane;
#pragma unroll
                for (int j = 0; j < 8; ++j) w[q][j] = xr[64 * j]; }
#pragma unroll
            for (int q = 0; q < 2; ++q) { const int r = r0 + q * NGW; if (r < MV) { const float rs = __builtin_amdgcn_rsqf(ss6[r] * (1.f / DM) + EPS);
                f32x4* yr = (f32x4*)(out + (size_t)r * DM) + lane; const f32x4* gr = (const f32x4*)a.in[14] + lane;
#pragma unroll
                for (int j = 0; j < 8; ++j) { const f32x4 g4 = gr[64 * j];
                    f32x4 y; y[0] = bflo(w[q][j].x) * rs * g4[0]; y[1] = bfhi(w[q][j].x) * rs * g4[1]; y[2] = bflo(w[q][j].y) * rs * g4[2]; y[3] = bfhi(w[q][j].y) * rs * g4[3]; __builtin_nontemporal_store(y, &yr[64 * j]); } } }
        }
    }
#undef IN
#undef SEAM
#undef XATTN_FFN
}

constexpr int N_PHASES = 23;

extern "C" void kernel_launch(void* const* d_in, const int* in_sizes, int n_in, void* d_out, int out_size, void* d_ws, size_t ws_size, hipStream_t stream) {
    static int grid = 0;
    if (grid == 0) {
        if (n_in != 32 || (size_t)out_size != O_END || ws_size < WS_END) { fprintf(stderr, "kernel_launch: unexpected shapes: n_in %d out %d (want %zu) ws %zu (want >= %zu)\n", n_in, out_size, (size_t)O_END, ws_size, (size_t)WS_END); grid = -1; return; }
        int dev = 0, cus = 0, per_cu = 0;
        if (hipGetDevice(&dev) != hipSuccess || hipDeviceGetAttribute(&cus, hipDeviceAttributeMultiprocessorCount, dev) != hipSuccess) { grid = -1; return; }
        if (hipFuncSetAttribute((const void*)mk_fwd, hipFuncAttributeMaxDynamicSharedMemorySize, LDS_BYTES) != hipSuccess) { fprintf(stderr, "kernel_launch: hipFuncSetAttribute failed\n"); grid = -1; return; }
        if (hipOccupancyMaxActiveBlocksPerMultiprocessor(&per_cu, (const void*)mk_fwd, 512, LDS_BYTES) != hipSuccess || per_cu < 1) { fprintf(stderr, "kernel_launch: occupancy query gave %d\n", per_cu); per_cu = 1; }
        (void)hipGetLastError();
        grid = cus * 1;
    }
    if (grid < 0) return;
    Args a{};
    for (int i = 0; i < 32; ++i) a.in[i] = (const float*)d_in[i];
    a.out = (float*)d_out; a.ws = (unsigned char*)d_ws;
    static bool per_phase = (MK_PER_PHASE != 0);
    if (!per_phase) {
        (void)hipMemsetAsync((unsigned char*)d_ws + WS_BAR, 0, 16384, stream);
        a.ph_lo = 0; a.ph_hi = N_PHASES;
        void* args[] = {&a};
        hipError_t e = hipLaunchCooperativeKernel((const void*)mk_fwd, dim3(grid), dim3(512), args, LDS_BYTES, stream);
        if (e == hipSuccess) return;
        fprintf(stderr, "kernel_launch: cooperative launch failed: %s (grid %d); falling back to one launch per phase\n", hipGetErrorString(e), grid);
        (void)hipGetLastError(); per_phase = true;
    }
    for (int p = 0; p < N_PHASES; ++p) { a.ph_lo = p; a.ph_hi = p + 1; hipLaunchKernelGGL(mk_fwd, dim3(grid), dim3(512), LDS_BYTES, stream, a); }
}
```

```cpp
#include <hip/hip_runtime.h>
#include <hip/hip_bf16.h>
#include <hip/hip_cooperative_groups.h>
#include <cstdio>
#include <cstdint>
namespace cg = cooperative_groups;

#ifndef MK_PER_PHASE
#define MK_PER_PHASE 0
#endif

#define LAS __attribute__((address_space(3)))
typedef unsigned short bf16_t;
typedef short bf16x8 __attribute__((ext_vector_type(8)));
typedef short s16x4 __attribute__((ext_vector_type(4)));
typedef float f32x2 __attribute__((ext_vector_type(2)));
typedef float f32x4 __attribute__((ext_vector_type(4)));
typedef float f32x16 __attribute__((ext_vector_type(16)));
typedef unsigned u32x2 __attribute__((ext_vector_type(2)));
typedef unsigned u32x4 __attribute__((ext_vector_type(4)));

constexpr int DM = 2048, SEQ = 4096, NB = 8, MP = NB * SEQ, MS = 128, MV = MP + MS, NTM = 129, MR = NTM * 256;
constexpr int DSQ = 16, PAST = 2048, NH = 16, HD = 128, DFF = 5632, NMEM = 256, MEMW = 512;
constexpr int NFIN = 6160, NFIN_PAD = 6400;
constexpr float EPS = 1e-6f;
constexpr float INV_SCALE = 11.313708498984761f;
constexpr float SM_SCALE = 0.08838834764831845f;

constexpr size_t O_YP = 0, O_YS = (size_t)MP * DM, O_PK = O_YS + (size_t)MS * DM, O_PV = O_PK + (size_t)MP * DM, O_PLF = O_PV + (size_t)MP * DM,
    O_PMK = O_PLF + (size_t)MP * NH, O_PMV = O_PMK + (size_t)2 * NB * NMEM * MEMW, O_PLH = O_PMV + (size_t)2 * NB * NMEM * MEMW, O_PLC = O_PLH + (size_t)NB * DM,
    O_SK = O_PLC + (size_t)NB * 3 * DM, O_SV = O_SK + (size_t)MS * DM, O_SLF = O_SV + (size_t)MS * DM, O_SLH = O_SLF + (size_t)MS * NH, O_SLC = O_SLH + (size_t)NB * DM,
    O_END = O_SLC + (size_t)NB * 3 * DM;

constexpr size_t al256(size_t x) { return (x + 255) & ~(size_t)255; }
constexpr size_t ACT_B = (size_t)MR * DM * 2;
constexpr size_t WS_WFIN = 0;
constexpr size_t WS_WFOUT = WS_WFIN + (size_t)NFIN_PAD * DM * 2;
constexpr size_t WS_WLIN = WS_WFOUT + (size_t)DM * DM * 2;
constexpr size_t WS_WGATE = WS_WLIN + (size_t)2 * DM * DM * 2;
constexpr size_t WS_WLOUT = WS_WGATE + (size_t)16 * 256 * 256 * 2;
constexpr size_t WS_WXQ = WS_WLOUT + (size_t)DM * DM * 2;
constexpr size_t WS_WXKV = WS_WXQ + (size_t)2 * MEMW * DM * 2;
constexpr size_t WS_WXO = WS_WXKV + (size_t)2 * 2 * MEMW * DM * 2;
constexpr size_t WS_WFFI = WS_WXO + (size_t)2 * DM * MEMW * 2;
constexpr size_t WS_WFFO = WS_WFFI + (size_t)2 * 2 * DFF * DM * 2;
constexpr size_t WS_XB = WS_WFFO + (size_t)2 * DM * DFF * 2;
constexpr size_t WS_BIG = WS_XB + ACT_B;
constexpr size_t WS_Q2 = WS_BIG + 4 * ACT_B;
constexpr size_t WS_MEMN = WS_Q2 + (size_t)MR * MEMW * 2;
constexpr size_t WS_MEMK = WS_MEMN + (size_t)2 * 2048 * DM * 2;
constexpr size_t WS_MEMV = WS_MEMK + (size_t)2 * 2048 * MEMW * 2;
constexpr size_t WS_SS = WS_MEMV + (size_t)2 * 2048 * MEMW * 2;
constexpr size_t WS_BIASP = al256(WS_SS + (size_t)7 * MR * 4);
constexpr int BIASS_LD = 2080;
constexpr size_t WS_BIASS = WS_BIASP + (size_t)NB * NH * SEQ * 4;
constexpr size_t WS_CA = al256(WS_BIASS + (size_t)2 * NB * NH * BIASS_LD * 4);
constexpr size_t WS_CB = WS_CA + (size_t)NB * 64 * DM * 4;
constexpr size_t WS_SPL = WS_CB + (size_t)NB * 64 * DM * 4;
constexpr size_t WS_BAR = al256(WS_SPL + (size_t)DM * 4);
constexpr size_t WS_END = WS_BAR + 16384;
static_assert((size_t)MR * DFF * 2 <= 4 * ACT_B, "H overlay");

constexpr int LDS_BYTES = 147456;

__device__ __forceinline__ unsigned cvt_pk_bf16(float lo, float hi) { unsigned r; asm volatile("v_cvt_pk_bf16_f32 %0, %1, %2" : "=v"(r) : "v"(lo), "v"(hi)); return r; }
__device__ __forceinline__ float bf2f(unsigned short b) { return __uint_as_float((unsigned)b << 16); }
__device__ __forceinline__ float bflo(unsigned w) { return __uint_as_float(w << 16); }
__device__ __forceinline__ float bfhi(unsigned w) { return __uint_as_float(w & 0xffff0000u); }
__device__ __forceinline__ u32x4 pack8f(f32x4 a, f32x4 b) { u32x4 w; w.x = cvt_pk_bf16(a[0], a[1]); w.y = cvt_pk_bf16(a[2], a[3]); w.z = cvt_pk_bf16(b[0], b[1]); w.w = cvt_pk_bf16(b[2], b[3]); return w; }
__device__ __forceinline__ float wave_sum(float v) {
#pragma unroll
    for (int o = 1; o < 64; o <<= 1) v += __shfl_xor(v, o);
    return v;
}
__device__ __forceinline__ float wave_max(float v) {
#pragma unroll
    for (int o = 1; o < 64; o <<= 1) v = fmaxf(v, __shfl_xor(v, o));
    return v;
}
__device__ __forceinline__ float sigmoidf_(float x) { return __builtin_amdgcn_rcpf(1.f + __expf(-x)); }
__device__ __forceinline__ float siluf_(float x) { return x * sigmoidf_(x); }
__device__ __forceinline__ float gelu_tanh_(float x) { return x * sigmoidf_(1.5957691216057308f * (x + 0.044715f * x * x * x)); }
__device__ __forceinline__ float logsigmoid_(float x) { return x < 0.f ? x - log1pf(__expf(x)) : -log1pf(__expf(-x)); }
#define LDS_WAIT() asm volatile("s_waitcnt lgkmcnt(0)" ::: "memory")

namespace pg8 {
#define PG8_LAS __attribute__((address_space(3)))
constexpr int BM = 256, BK = 64, HALF = 128, HTB = HALF * BK * 2, STAGE_BYTES = 8 * HTB, NXCD = 8, WGM = 8;
__host__ __device__ __forceinline__ int lds_byte(int r, int c) { const int st = (r >> 4) * 2 + (c >> 5), rr = r & 15, cc = c & 31, ob = rr * 64 + cc * 2; return st * 1024 + (ob ^ (((ob >> 9) & 1) << 5)); }
__host__ __device__ __forceinline__ void stage_rc(int b, int& R, int& C) { const int st = b / 1024, sb = b % 1024, swz = sb ^ (((sb >> 9) & 1) << 5); R = (st >> 1) * 16 + swz / 64; C = (st & 1) * 32 + (swz % 64) / 2; }
__host__ __device__ __forceinline__ int perm32(int rho) { const int n = rho >> 4, i = rho & 15; return 8 * (i >> 2) + 4 * n + (i & 3); }

struct Unit { int pm, pn; };
struct Gemm { const bf16_t* A; const bf16_t* Bt; int lda, ldb, K, akoff, bdiv, bstride, hpm; };
__device__ __forceinline__ const char* abase(const Gemm& g, const Unit& u) { return (const char*)(g.A + (size_t)u.pm * BM * g.lda + (size_t)(u.pn >> 1) * g.akoff); }
__device__ __forceinline__ const char* bbase(const Gemm& g, const Unit& u) { return (const char*)(g.Bt + ((size_t)u.pn * BM + (size_t)(u.pm / g.bdiv) * g.bstride) * g.ldb); }

struct StaticOrder {
    int nM, nN, nwg, G, c;
    __device__ void init(int nM_, int nN_, int G_, int c_) { nM = nM_; nN = nN_; nwg = nM * nN; G = G_; c = c_; }
    __device__ bool next(int i, Unit& u) const {
        const long L = (long)i * G + c; if (L >= nwg) return false;
        int wgid = (int)L; { const int q = nwg / NXCD, r = nwg % NXCD, xcd = wgid % NXCD, off = wgid / NXCD; wgid = (xcd < r ? xcd * (q + 1) : r * (q + 1) + (xcd - r) * q) + off; }
        const int nig = WGM * nN, gid = wgid / nig, fm = gid * WGM, gsz = (nM - fm) < WGM ? (nM - fm) : WGM;
        u.pm = fm + ((wgid % nig) % gsz); u.pn = (wgid % nig) / gsz; return true;
    }
};

template <class Epi>
__device__ __forceinline__ void gemm_phase(PG8_LAS unsigned char* lds, const Gemm g, const StaticOrder& S, const Epi& E) {
    const int tid = threadIdx.x, wid = __builtin_amdgcn_readfirstlane(tid >> 6), lane = tid & 63, wr = wid >> 2, wc = wid & 3, fr = lane & 15, fq = lane >> 4;
    int K = g.K; asm volatile("" : "+s"(K)); const int nt = K / BK;
    unsigned voffA[2], voffB[2];
#pragma unroll
    for (int i = 0; i < 2; ++i) { int R, C; stage_rc(tid * 16 + i * 8192, R, C); const int Rb = (R & ~31) + perm32(R & 31);
        voffA[i] = (unsigned)(R * g.lda + C) * 2u; voffB[i] = (unsigned)(Rb * g.ldb + C) * 2u; }
    const size_t kstep = (size_t)(BK * 2);
    const size_t hstepA = (size_t)HALF * g.lda * 2, hstepB = (size_t)HALF * g.ldb * 2;
    const unsigned ldsw = (unsigned)wid * 1024u;
    const int aoff = lds_byte(wr * 64 + fr, fq * 8), boff = lds_byte(wc * 32 + fr, fq * 8);
#define PG8_SA(b, h) (((b) * 2 + (h)) * HTB)
#define PG8_SB(b, h) ((4 + (b) * 2 + (h)) * HTB)
#define PG8_STAGE(bufoff, gbase, voff) do { _Pragma("unroll") for (int _i = 0; _i < 2; ++_i) \
        __builtin_amdgcn_global_load_lds((const unsigned*)((const char*)(gbase) + (voff)[_i]), (PG8_LAS unsigned*)(lds + (bufoff) + ldsw + _i * 8192), 16, 0, 0); } while (0)
#define PG8_LDA(dst, b, h) do { _Pragma("unroll") for (int m = 0; m < 4; ++m) _Pragma("unroll") for (int k = 0; k < 2; ++k) dst[m][k] = *(const PG8_LAS bf16x8*)(lds + PG8_SA(b, h) + aoff + m * 2048 + k * 1024); } while (0)
#define PG8_LDB(dst, b, h) do { _Pragma("unroll") for (int n = 0; n < 2; ++n) _Pragma("unroll") for (int k = 0; k < 2; ++k) dst[n][k] = *(const PG8_LAS bf16x8*)(lds + PG8_SB(b, h) + boff + n * 2048 + k * 1024); } while (0)
#define PG8_MMA(ai, bj, At, Bt) do { __builtin_amdgcn_s_setprio(1); _Pragma("unroll") for (int m = 0; m < 4; ++m) _Pragma("unroll") for (int n = 0; n < 2; ++n) _Pragma("unroll") for (int k = 0; k < 2; ++k) \
        acc[ai][bj][m][n] = __builtin_amdgcn_mfma_f32_16x16x32_bf16(Bt[n][k], At[m][k], acc[ai][bj][m][n], 0, 0, 0); __builtin_amdgcn_s_setprio(0); } while (0)
#define PG8_WAIT_V(n) asm volatile("s_waitcnt vmcnt(" #n ")" ::: "memory")
#define PG8_WAIT_L(n) asm volatile("s_waitcnt lgkmcnt(" #n ")" ::: "memory")
#define PG8_BAR __builtin_amdgcn_s_barrier()
#define PG8_SCHED __builtin_amdgcn_sched_barrier(0)
    Unit cur, nxt; int ui = 0;
    if (!S.next(0, cur)) return;
    f32x4 acc[2][2][4][2];
#pragma unroll
    for (int a = 0; a < 2; ++a)
#pragma unroll
        for (int b = 0; b < 2; ++b)
#pragma unroll
            for (int m = 0; m < 4; ++m)
#pragma unroll
                for (int n = 0; n < 2; ++n) acc[a][b][m][n] = (f32x4){0.f, 0.f, 0.f, 0.f};
    bf16x8 At[4][2], B0[2][2], B1[2][2];
    const char* cA = abase(g, cur); const char* cB = bbase(g, cur); bool fullc = cur.pm != g.hpm;
    PG8_STAGE(PG8_SB(0, 0), cB, voffB); PG8_STAGE(PG8_SB(0, 1), cB + hstepB, voffB); PG8_STAGE(PG8_SA(0, 0), cA, voffA); PG8_STAGE(PG8_SA(0, 1), cA + hstepA, voffA);
    if (wr == 1) PG8_BAR;
    PG8_WAIT_V(2); PG8_BAR;
    PG8_STAGE(PG8_SB(1, 0), cB + kstep, voffB); PG8_STAGE(PG8_SA(1, 0), cA + kstep, voffA); PG8_STAGE(PG8_SB(1, 1), cB + hstepB + kstep, voffB);
    PG8_WAIT_V(6); PG8_BAR;
    for (;;) {
        const bool has_next = S.next(ui + 1, nxt);
        const char* nA = has_next ? abase(g, nxt) : cA; const char* nB = has_next ? bbase(g, nxt) : cB;
        for (int t = 0; t < nt; t += 2) {
            const bool last = (t == nt - 2);
            const char* a1 = cA + (size_t)(t + 1) * kstep;
            const char* a2 = last ? nA : cA + (size_t)(t + 2) * kstep; const char* b2 = last ? nB : cB + (size_t)(t + 2) * kstep;
            const char* a3 = a2 + kstep; const char* b3 = b2 + kstep;
            PG8_LDB(B0, 0, 0); PG8_LDB(B1, 0, 1); PG8_SCHED; PG8_LDA(At, 0, 0); PG8_STAGE(PG8_SA(1, 1), a1 + hstepA, voffA);
            PG8_WAIT_V(8); PG8_WAIT_L(0); PG8_BAR; PG8_MMA(0, 0, At, B0); PG8_MMA(0, 1, At, B1); PG8_BAR; PG8_SCHED;
            PG8_LDA(At, 0, 1); PG8_STAGE(PG8_SB(0, 0), b2, voffB); PG8_STAGE(PG8_SB(0, 1), b2 + hstepB, voffB); PG8_STAGE(PG8_SA(0, 0), a2, voffA);
            PG8_WAIT_V(8); PG8_WAIT_L(0); PG8_BAR; if (fullc) { PG8_MMA(1, 0, At, B0); PG8_MMA(1, 1, At, B1); } PG8_BAR; PG8_SCHED;
            PG8_LDB(B0, 1, 0); PG8_LDB(B1, 1, 1); PG8_SCHED; PG8_LDA(At, 1, 0); PG8_STAGE(PG8_SA(0, 1), a2 + hstepA, voffA);
            PG8_WAIT_V(8); PG8_WAIT_L(0); PG8_BAR; PG8_MMA(0, 0, At, B0); PG8_MMA(0, 1, At, B1); PG8_BAR; PG8_SCHED;
            PG8_LDA(At, 1, 1); PG8_STAGE(PG8_SB(1, 0), b3, voffB); PG8_STAGE(PG8_SB(1, 1), b3 + hstepB, voffB); PG8_STAGE(PG8_SA(1, 0), a3, voffA);
            PG8_WAIT_V(8); PG8_WAIT_L(0); PG8_BAR; if (fullc) { PG8_MMA(1, 0, At, B0); PG8_MMA(1, 1, At, B1); } PG8_BAR; PG8_SCHED;
        }
        if (wr == 0) PG8_BAR;
        E(acc, cur, wr, wc, fr, fq);
        if (!has_next) break;
#pragma unroll
        for (int a = 0; a < 2; ++a)
#pragma unroll
            for (int b = 0; b < 2; ++b)
#pragma unroll
                for (int m = 0; m < 4; ++m)
#pragma unroll
                    for (int n = 0; n < 2; ++n) acc[a][b][m][n] = (f32x4){0.f, 0.f, 0.f, 0.f};
        cur = nxt; cA = nA; cB = nB; ++ui; fullc = cur.pm != g.hpm;
        if (wr == 1) PG8_BAR;
    }
    PG8_WAIT_V(0);
    PG8_BAR;
#undef PG8_SA
#undef PG8_SB
#undef PG8_STAGE
#undef PG8_LDA
#undef PG8_LDB
#undef PG8_MMA
#undef PG8_WAIT_V
#undef PG8_WAIT_L
#undef PG8_BAR
#undef PG8_SCHED
}

typedef const f32x4 (&AccT)[2][2][4][2];
__device__ __forceinline__ float rstd_of(const float* ss, int row) { return __builtin_amdgcn_rsqf(ss[row] * (1.0f / DM) + EPS); }

struct EpiFoxIn {
    const float* ss; bf16_t* Qb; bf16_t* Kb; bf16_t* Vb; float* out; const float* b_f;
    __device__ __forceinline__ void operator()(AccT acc, const Unit& u, int wr, int wc, int fr, int fq) const {
        const int row0 = u.pm * BM + wr * 64 + fr;
        if (u.pn < 24) {
            const int t = u.pn >> 3; const int colt = (u.pn & 7) * BM + wc * 32 + 8 * fq;
            bf16_t* bb = Qb + (size_t)t * (ACT_B / 2);
#pragma unroll
            for (int ai = 0; ai < 2; ++ai)
#pragma unroll
                for (int m = 0; m < 4; ++m) { const int row = row0 + ai * HALF + m * 16; const float rs = rstd_of(ss, row);
                    float* fo = nullptr;
                    if (t >= 1) { if (row < MP) { if ((row & (SEQ - 1)) < 64) fo = out + O_PK + (size_t)(t - 1) * ((size_t)MP * DM) + (size_t)row * DM; } else if (row < MV) fo = out + O_SK + (size_t)(t - 1) * ((size_t)MS * DM) + (size_t)(row - MP) * DM; }
#pragma unroll
                    for (int bj = 0; bj < 2; ++bj) { const f32x4 v0 = acc[ai][bj][m][0] * rs, v1 = acc[ai][bj][m][1] * rs; const int col = colt + bj * HALF;
                        *(u32x4*)(bb + (size_t)row * DM + col) = pack8f(v0, v1);
                        if (fo) { __builtin_nontemporal_store(v0, (f32x4*)(fo + col)); __builtin_nontemporal_store(v1, (f32x4*)(fo + col + 4)); } } }
        } else if (wc == 0 && fq < 2) {
            const int col = 8 * fq; const f32x4 b0 = *(const f32x4*)(b_f + col), b1 = *(const f32x4*)(b_f + col + 4);
#pragma unroll
            for (int ai = 0; ai < 2; ++ai)
#pragma unroll
                for (int m = 0; m < 4; ++m) { const int row = row0 + ai * HALF + m * 16; const float rs = rstd_of(ss, row);
                    float* fo = nullptr; if (row < MP) fo = out + O_PLF + (size_t)row * NH; else if (row < MV) fo = out + O_SLF + (size_t)(row - MP) * NH;
                    if (fo) { f32x4 v0 = acc[ai][0][m][0] * rs + b0, v1 = acc[ai][0][m][1] * rs + b1;
#pragma unroll
                        for (int j = 0; j < 4; ++j) { v0[j] = logsigmoid_(v0[j]); v1[j] = logsigmoid_(v1[j]); }
                        *(f32x4*)(fo + col) = v0; *(f32x4*)(fo + col + 4) = v1; } }
        }
    }
};
struct EpiRes {
    bf16_t* xb; float* ss_out;
    __device__ __forceinline__ void operator()(AccT acc, const Unit& u, int wr, int wc, int fr, int fq) const {
        const int row0 = u.pm * BM + wr * 64 + fr; const int colt = u.pn * BM + wc * 32 + 8 * fq;
        u32x4 xo[2][4][2];
#pragma unroll
        for (int ai = 0; ai < 2; ++ai)
#pragma unroll
            for (int m = 0; m < 4; ++m)
#pragma unroll
                for (int bj = 0; bj < 2; ++bj) xo[ai][m][bj] = *(const u32x4*)(xb + (size_t)(row0 + ai * HALF + m * 16) * DM + colt + bj * HALF);
        asm volatile("" ::: "memory");
        float sq[2][4];
#pragma unroll
        for (int ai = 0; ai < 2; ++ai)
#pragma unroll
            for (int m = 0; m < 4; ++m) { const int row = row0 + ai * HALF + m * 16;
                float s = 0.f;
#pragma unroll
                for (int bj = 0; bj < 2; ++bj) { bf16_t* px = xb + (size_t)row * DM + colt + bj * HALF; const u32x4 x4 = xo[ai][m][bj];
                    f32x4 v0 = acc[ai][bj][m][0], v1 = acc[ai][bj][m][1];
                    v0[0] += bflo(x4[0]); v0[1] += bfhi(x4[0]); v0[2] += bflo(x4[1]); v0[3] += bfhi(x4[1]);
                    v1[0] += bflo(x4[2]); v1[1] += bfhi(x4[2]); v1[2] += bflo(x4[3]); v1[3] += bfhi(x4[3]);
                    *(u32x4*)px = pack8f(v0, v1);
                    s += (v0[0] * v0[0] + v0[1] * v0[1]) + (v0[2] * v0[2] + v0[3] * v0[3]) + (v1[0] * v1[0] + v1[1] * v1[1]) + (v1[2] * v1[2] + v1[3] * v1[3]); }
                s += __shfl_xor(s, 16); s += __shfl_xor(s, 32);
                sq[ai][m] = s; }
        const float k0 = fq == 0 ? 1.f : 0.f, k1 = fq == 1 ? 1.f : 0.f, k2 = fq == 2 ? 1.f : 0.f, k3 = fq == 3 ? 1.f : 0.f;
#pragma unroll
        for (int ai = 0; ai < 2; ++ai) { const float v = (k0 * sq[ai][0] + k1 * sq[ai][1]) + (k2 * sq[ai][2] + k3 * sq[ai][3]);
            const int row = row0 + ai * HALF + fq * 16;
            if (row < MV) __hip_atomic_fetch_add(ss_out + row, v, __ATOMIC_RELAXED, __HIP_MEMORY_SCOPE_AGENT); }
    }
};
struct EpiScale {
    const float* ss; bf16_t* O; int ldc;
    __device__ __forceinline__ void operator()(AccT acc, const Unit& u, int wr, int wc, int fr, int fq) const {
        const int row0 = u.pm * BM + wr * 64 + fr; const int colt = u.pn * BM + wc * 32 + 8 * fq;
#pragma unroll
        for (int ai = 0; ai < 2; ++ai)
#pragma unroll
            for (int m = 0; m < 4; ++m) { const int row = row0 + ai * HALF + m * 16; const float rs = rstd_of(ss, row);
#pragma unroll
                for (int bj = 0; bj < 2; ++bj) *(u32x4*)(O + (size_t)row * ldc + colt + bj * HALF) = pack8f(acc[ai][bj][m][0] * rs, acc[ai][bj][m][1] * rs); }
    }
};
struct EpiSwiglu {
    const float* ss; bf16_t* H;
    __device__ __forceinline__ void operator()(AccT acc, const Unit& u, int wr, int wc, int fr, int fq) const {
        const int row0 = u.pm * BM + wr * 64 + fr; const int col = u.pn * HALF + wc * 32 + 8 * fq;
#pragma unroll
        for (int ai = 0; ai < 2; ++ai)
#pragma unroll
            for (int m = 0; m < 4; ++m) { const int row = row0 + ai * HALF + m * 16; const float rs = rstd_of(ss, row);
                f32x4 o0, o1;
#pragma unroll
                for (int j = 0; j < 4; ++j) { o0[j] = siluf_(acc[ai][0][m][0][j] * rs) * (acc[ai][1][m][0][j] * rs); o1[j] = siluf_(acc[ai][0][m][1][j] * rs) * (acc[ai][1][m][1][j] * rs); }
                *(u32x4*)(H + (size_t)row * DFF + col) = pack8f(o0, o1); }
    }
};
struct EpiLruIn {
    const float* ss; bf16_t* G; bf16_t* U; float* out;
    __device__ __forceinline__ void operator()(AccT acc, const Unit& u, int wr, int wc, int fr, int fq) const {
        const int row0 = u.pm * BM + wr * 64 + fr; const bool isg = u.pn < 8; const int colt = (u.pn & 7) * BM + wc * 32 + 8 * fq;
#pragma unroll
        for (int ai = 0; ai < 2; ++ai)
#pragma unroll
            for (int m = 0; m < 4; ++m) { const int row = row0 + ai * HALF + m * 16; const float rs = rstd_of(ss, row);
                float* fo = nullptr;
                if (!isg) { if (row < MP) { const int t = row & (SEQ - 1); if (t >= SEQ - 3) fo = out + O_PLC + ((size_t)(row >> 12) * 3 + (t - (SEQ - 3))) * DM; }
                            else if (row < MV) { const int t = (row - MP) & 15; if (t >= 13) fo = out + O_SLC + ((size_t)((row - MP) >> 4) * 3 + (t - 13)) * DM; } }
#pragma unroll
                for (int bj = 0; bj < 2; ++bj) { f32x4 v0 = acc[ai][bj][m][0] * rs, v1 = acc[ai][bj][m][1] * rs; const int col = colt + bj * HALF;
                    if (isg) {
#pragma unroll
                        for (int j = 0; j < 4; ++j) { v0[j] = gelu_tanh_(v0[j]); v1[j] = gelu_tanh_(v1[j]); }
                        *(u32x4*)(G + (size_t)row * DM + col) = pack8f(v0, v1);
                    } else { *(u32x4*)(U + (size_t)row * DM + col) = pack8f(v0, v1);
                        if (fo) { *(f32x4*)(fo + col) = v0; *(f32x4*)(fo + col + 4) = v1; } } } }
    }
};
struct EpiGates {
    const bf16_t* UC; const float* b_a; const float* b_x; const float* spl; bf16_t* LA; bf16_t* BB;
    __device__ __forceinline__ void operator()(AccT acc, const Unit& u, int wr, int wc, int fr, int fq) const {
        const int row0 = u.pm * BM + wr * 64 + fr; const int ch = u.pn * HALF + wc * 32 + 8 * fq;
        u32x4 ucw[2][4];
#pragma unroll
        for (int ai = 0; ai < 2; ++ai)
#pragma unroll
            for (int m = 0; m < 4; ++m) ucw[ai][m] = *(const u32x4*)(UC + (size_t)(row0 + ai * HALF + m * 16) * DM + ch);
        const f32x4 ba0 = *(const f32x4*)(b_a + ch), ba1 = *(const f32x4*)(b_a + ch + 4), bx0 = *(const f32x4*)(b_x + ch), bx1 = *(const f32x4*)(b_x + ch + 4);
        const f32x4 sp0 = *(const f32x4*)(spl + ch), sp1 = *(const f32x4*)(spl + ch + 4);
        asm volatile("" ::: "memory");
#pragma unroll
        for (int ai = 0; ai < 2; ++ai)
#pragma unroll
            for (int m = 0; m < 4; ++m) { int row = row0 + ai * HALF + m * 16; asm volatile("" : "+v"(row));
                f32x4 la0, la1, b0, b1;
#pragma unroll
                for (int j = 0; j < 4; ++j) {
                    la0[j] = -sp0[j] * sigmoidf_(acc[ai][0][m][0][j] + ba0[j]); la1[j] = -sp1[j] * sigmoidf_(acc[ai][0][m][1][j] + ba1[j]);
                    const unsigned w0 = ucw[ai][m][j >> 1], w1 = ucw[ai][m][2 + (j >> 1)];
                    b0[j] = sigmoidf_(acc[ai][1][m][0][j] + bx0[j]) * ((j & 1) ? bfhi(w0) : bflo(w0));
                    b1[j] = sigmoidf_(acc[ai][1][m][1][j] + bx1[j]) * ((j & 1) ? bfhi(w1) : bflo(w1)); }
                *(u32x4*)(LA + (size_t)row * DM + ch) = pack8f(la0, la1); *(u32x4*)(BB + (size_t)row * DM + ch) = pack8f(b0, b1); }
    }
};
struct EpiMemKV {
    float* out; bf16_t* KB; bf16_t* VB;
    __device__ __forceinline__ void operator()(AccT acc, const Unit& u, int wr, int wc, int fr, int fq) const {
        const int row0 = u.pm * BM + wr * 64 + fr; const bool isk = u.pn < 2; const int colt = (u.pn & 1) * BM + wc * 32 + 8 * fq;
        float* fo = out + O_PMK + (isk ? (size_t)0 : (size_t)(O_PMV - O_PMK)); bf16_t* bo = KB + (isk ? (size_t)0 : (size_t)2 * 2048 * MEMW);
#pragma unroll
        for (int ai = 0; ai < 2; ++ai)
#pragma unroll
            for (int m = 0; m < 4; ++m) { const int row = row0 + ai * HALF + m * 16;
#pragma unroll
                for (int bj = 0; bj < 2; ++bj) { const f32x4 v0 = acc[ai][bj][m][0], v1 = acc[ai][bj][m][1]; const int col = colt + bj * HALF;
                    *(u32x4*)(bo + (size_t)row * MEMW + col) = pack8f(v0, v1);
                    *(f32x4*)(fo + (size_t)row * MEMW + col) = v0; *(f32x4*)(fo + (size_t)row * MEMW + col + 4) = v1; } }
    }
};
}

namespace att {
using bf16 = __hip_bfloat16;
constexpr int D = 128, NW = 8, QBLK = 32, KVBLK = 64, QB = NW * QBLK;
constexpr int SHM_V = KVBLK * D * 2, SHM_K = KVBLK * D * 2;
constexpr int LDS_WS = 2 * SHM_V + 2 * SHM_K, LDS_BIAS = LDS_WS + NW * 64 * 4, ATT_LDS_BYTES = LDS_BIAS + 4096 * 4;
constexpr float SCALE = SM_SCALE, THR = 8.f;
#define KSWZ(row, colB) ((row) * 256 + ((colB) ^ (((row) & 7) << 4)))
#define SBAR() __builtin_amdgcn_sched_barrier(0)
__device__ __forceinline__ int v_st(int k, int c) { const int kk = (k & ~0xC) | ((k & 4) << 1) | ((k & 8) >> 1); return ((kk >> 3) * 4 + (c >> 5)) * 512 + ((kk & 7) * 32 + (c & 31)) * 2; }
__device__ __forceinline__ int v_rd_base(int lane) { return ((lane & 3) << 3) | (((lane >> 2) & 3) << 6) | (((lane >> 4) & 1) << 5) | (((lane >> 5) & 1) << 8); }
constexpr int v_rd_off(int d0, int ks, int half) { return d0 * 512 + ks * 4096 + half * 2048; }
__device__ __forceinline__ int crow(int r, int hi) { return (r & 3) + 8 * (r >> 2) + 4 * hi; }
__device__ __forceinline__ bf16x8 load8(const bf16* p) { return *reinterpret_cast<const bf16x8*>(p); }
__device__ __forceinline__ void mask_tile(f32x16& p0, f32x16& p1, int dq, unsigned W) {
    const float NEG = -__builtin_inff();
#pragma unroll
    for (int r = 0; r < 16; ++r) { const int c = (r & 3) + 8 * (r >> 2);
        if ((unsigned)(dq - c) >= W) p0[r] = NEG;
        if ((unsigned)(dq - c - 32) >= W) p1[r] = NEG; }
}
__device__ __forceinline__ void partialSM(f32x16& p0, f32x16& p1, float& m_reg, float& mn, float& alpha) {
    float pmax = p0[0];
#pragma unroll
    for (int r = 1; r < 16; ++r) pmax = fmaxf(pmax, p0[r]);
#pragma unroll
    for (int r = 0; r < 16; ++r) pmax = fmaxf(pmax, p1[r]);
    { auto rr = __builtin_amdgcn_permlane32_swap(__float_as_uint(pmax), __float_as_uint(pmax), false, false);
      pmax = fmaxf(__uint_as_float(rr[0]), __uint_as_float(rr[1])); }
    constexpr float C2 = 1.4426950408889634f * SCALE;
    if (__builtin_expect(__all((pmax - m_reg) * SCALE <= THR), 1)) { mn = m_reg; alpha = 1.f; }
    else { mn = fmaxf(m_reg, pmax); alpha = __builtin_amdgcn_exp2f((m_reg - mn) * C2); m_reg = mn; }
    const float mnL = -mn * C2;
#pragma unroll
    for (int r = 0; r < 16; ++r) p0[r] = fmaf(p0[r], C2, mnL);
#pragma unroll
    for (int r = 0; r < 16; ++r) p1[r] = fmaf(p1[r], C2, mnL);
#pragma unroll
    for (int r = 0; r < 16; ++r) p0[r] = __builtin_amdgcn_exp2f(p0[r]);
}
__device__ __forceinline__ void finishSM(f32x16& p0, f32x16& p1, float alpha, float& l_reg, bf16x8& pa0, bf16x8& pa1, bf16x8& pa2, bf16x8& pa3) {
#pragma unroll
    for (int r = 0; r < 16; ++r) p1[r] = __builtin_amdgcn_exp2f(p1[r]);
    float ps = 0;
#pragma unroll
    for (int r = 0; r < 16; ++r) ps += p0[r];
#pragma unroll
    for (int r = 0; r < 16; ++r) ps += p1[r];
    { auto rr = __builtin_amdgcn_permlane32_swap(__float_as_uint(ps), __float_as_uint(ps), false, false);
      ps = __uint_as_float(rr[0]) + __uint_as_float(rr[1]); }
    l_reg = l_reg * alpha + ps;
#define PK4(P, B_, OUT) do { unsigned a0 = cvt_pk_bf16(P[B_+0], P[B_+1]), a1 = cvt_pk_bf16(P[B_+2], P[B_+3]);                          \
        unsigned b0 = cvt_pk_bf16(P[B_+4], P[B_+5]), b1 = cvt_pk_bf16(P[B_+6], P[B_+7]);                                             \
        auto r0 = __builtin_amdgcn_permlane32_swap(a0, b0, false, false); auto r1 = __builtin_amdgcn_permlane32_swap(a1, b1, false, false); \
        u32x4 w = {r0[0], r1[0], r0[1], r1[1]}; OUT = *reinterpret_cast<bf16x8*>(&w); } while (0)
    PK4(p0, 0, pa0); PK4(p0, 8, pa1); PK4(p1, 0, pa2); PK4(p1, 8, pa3);
#undef PK4
}
template <int KB, bool HB>
__device__ __forceinline__ void qkt(f32x16& p0, f32x16& p1, const char* lds, int r32, int hi, const bf16x8* qr, int kbase) {
    const char* K_lds = lds + 2 * SHM_V;
    if (HB) { const char* bl = lds + LDS_BIAS + kbase * 4 + hi * 16;
#pragma unroll
        for (int j = 0; j < 4; ++j) { const f32x4 a = *(const f32x4*)(bl + j * 32), b = *(const f32x4*)(bl + 128 + j * 32);
#pragma unroll
            for (int i = 0; i < 4; ++i) { p0[4 * j + i] = a[i]; p1[4 * j + i] = b[i]; } }
    } else { p0 = f32x16{}; p1 = f32x16{}; }
    const char* kb[4];
#pragma unroll
    for (int dd = 0; dd < 4; ++dd) kb[dd] = K_lds + KB * SHM_K + KSWZ(r32, (dd * 16 + hi * 8) * 2);
#pragma unroll
    for (int d0 = 0; d0 < 8; ++d0) { const char* a = kb[d0 & 3] + (d0 >> 2) * 128;
        bf16x8 b0 = *reinterpret_cast<const bf16x8*>(a);
        bf16x8 b1 = *reinterpret_cast<const bf16x8*>(a + 32 * 256);
        p0 = __builtin_amdgcn_mfma_f32_32x32x16_bf16(b0, qr[d0], p0, 0, 0, 0);
        p1 = __builtin_amdgcn_mfma_f32_32x32x16_bf16(b1, qr[d0], p1, 0, 0, 0); }
}
template <int VB>
__device__ __forceinline__ void pv_tile(f32x16* o, int vb0, bf16x8 pa0, bf16x8 pa1, bf16x8 pa2, bf16x8 pa3) {
#define TRRD(dst, off) asm volatile("ds_read_b64_tr_b16 %0, %1 offset:%2" : "=&v"(dst) : "v"(vb0), "i"(off) : "memory")
#define PV_D0(d0) do { s16x4 l0, l1, l2, l3, h0, h1, h2, h3; constexpr int b_ = VB * SHM_V + v_rd_off(d0, 0, 0); \
        TRRD(l0, b_); TRRD(h0, b_ + 2048); TRRD(l1, b_ + 4096); TRRD(h1, b_ + 6144); TRRD(l2, b_ + 8192); TRRD(h2, b_ + 10240); TRRD(l3, b_ + 12288); TRRD(h3, b_ + 14336); \
        asm volatile("s_waitcnt lgkmcnt(0)" ::: "memory"); SBAR();   \
        o[d0] = __builtin_amdgcn_mfma_f32_32x32x16_bf16(pa0, (bf16x8){l0[0], l0[1], l0[2], l0[3], h0[0], h0[1], h0[2], h0[3]}, o[d0], 0, 0, 0);   \
        o[d0] = __builtin_amdgcn_mfma_f32_32x32x16_bf16(pa1, (bf16x8){l1[0], l1[1], l1[2], l1[3], h1[0], h1[1], h1[2], h1[3]}, o[d0], 0, 0, 0);   \
        o[d0] = __builtin_amdgcn_mfma_f32_32x32x16_bf16(pa2, (bf16x8){l2[0], l2[1], l2[2], l2[3], h2[0], h2[1], h2[2], h2[3]}, o[d0], 0, 0, 0);   \
        o[d0] = __builtin_amdgcn_mfma_f32_32x32x16_bf16(pa3, (bf16x8){l3[0], l3[1], l3[2], l3[3], h3[0], h3[1], h3[2], h3[3]}, o[d0], 0, 0, 0); } while (0)
    PV_D0(0); PV_D0(1); PV_D0(2); PV_D0(3);
#undef PV_D0
#undef TRRD
}
struct BlockRef { const bf16* Q; const bf16* K; const bf16* V; bf16* O; const float* cb; float* fk; float* fv; int P0; };
struct Seam { bf16x8 qr[8]; bf16x8 st_v0, st_v1, st_k0, st_k1; };
__device__ __forceinline__ int swa_jlo(int P0, int W) { const int lowk = P0 - W + 1; return lowk > 0 ? lowk / KVBLK : 0; }
#define ROW(p, k0, rr) ((p) + (size_t)((k0) + (rr)) * RSK + sc)
#define VMW() asm volatile("s_waitcnt vmcnt(0)" ::: "memory")
#define VMWN(n) asm volatile("s_waitcnt vmcnt(%0)" :: "i"(n) : "memory")
#define STG_IDX() int t_ = threadIdx.x; asm volatile("" : "+v"(t_)); const int sr = t_ >> 4, sc = (t_ & 15) * 8
#define SLOAD_H(R_, k0) do { STG_IDX(); S.st_v0 = load8(ROW((R_).V, k0, sr)); S.st_v1 = load8(ROW((R_).V, k0, 32 + sr));              \
                         S.st_k0 = load8(ROW((R_).K, k0, sr)); S.st_k1 = load8(ROW((R_).K, k0, 32 + sr)); } while (0)
#define SWRITE_HK(bf) do { STG_IDX(); const int kws = KSWZ(sr, sc * 2); *(bf16x8*)(K_lds + (bf) * SHM_K + kws) = S.st_k0; *(bf16x8*)(K_lds + (bf) * SHM_K + kws + 32 * 256) = S.st_k1; } while (0)
#define SWRITE_HV(bf) do { STG_IDX(); const int vst0 = v_st(sr, sc), vst1 = v_st(32 + sr, sc); *(bf16x8*)(V_lds + (bf) * SHM_V + vst0) = S.st_v0; *(bf16x8*)(V_lds + (bf) * SHM_V + vst1) = S.st_v1; } while (0)
#define SWRITE_H(bf) do { SWRITE_HV(bf); SWRITE_HK(bf); } while (0)
#define BF8_TO_F32_STORE(dst, v8) do { const u32x4 w_ = __builtin_bit_cast(u32x4, v8); \
        __builtin_nontemporal_store((f32x4){bflo(w_[0]), bfhi(w_[0]), bflo(w_[1]), bfhi(w_[1])}, (f32x4*)(dst)); \
        __builtin_nontemporal_store((f32x4){bflo(w_[2]), bfhi(w_[2]), bflo(w_[3]), bfhi(w_[3])}, (f32x4*)(dst) + 1); } while (0)
#define KV_OUT(k0) do { if (HB) { if ((k0) >= cur.P0) { STG_IDX(); float* dk_ = cur.fk + (size_t)((k0) + sr) * RSK + sc; float* dv_ = cur.fv + (size_t)((k0) + sr) * RSK + sc; \
        BF8_TO_F32_STORE(dk_, S.st_k0); BF8_TO_F32_STORE(dk_ + (size_t)32 * RSK, S.st_k1); BF8_TO_F32_STORE(dv_, S.st_v0); BF8_TO_F32_STORE(dv_ + (size_t)32 * RSK, S.st_v1); } } } while (0)
template <int RSQ, int RSK, bool HB>
__device__ __forceinline__ void att_prime(const BlockRef& cur, int W, char* lds, Seam& S) {
    const int tid = threadIdx.x, wid = __builtin_amdgcn_readfirstlane(tid >> 6), lane = tid & 63, r32 = lane & 31, hi = lane >> 5;
    char* K_lds = lds + 2 * SHM_V;
    const int kb0 = swa_jlo(cur.P0, W) * KVBLK;
#pragma unroll
    for (int d0 = 0; d0 < 8; ++d0) S.qr[d0] = load8(cur.Q + (size_t)(wid * QBLK + r32) * RSQ + d0 * 16 + hi * 8);
    SLOAD_H(cur, kb0); VMW(); SWRITE_HK(0);
    __syncthreads();
}
template <int RSQ, int RSK, bool HB>
__device__ __forceinline__ void att_block(const BlockRef& cur, const BlockRef& nxt, int skv, int W, char* lds, Seam& S) {
    const int tid = threadIdx.x, wid = __builtin_amdgcn_readfirstlane(tid >> 6), lane = tid & 63, r32 = lane & 31, hi = lane >> 5;
    const int j_lo = swa_jlo(cur.P0, W);
    int j_hi = (cur.P0 + QB - 1) / KVBLK + 1; if (j_hi > skv / KVBLK) j_hi = skv / KVBLK;
    const int NT = j_hi - j_lo;
    const int kbn = swa_jlo(nxt.P0, W) * KVBLK;
    const int qlo = cur.P0 + wid * QBLK, qm = qlo + r32 - 4 * hi;
    char* V_lds = lds; char* K_lds = lds + 2 * SHM_V;
    float* ws = (float*)(lds + LDS_WS) + wid * 64; float* li_l = ws, * al_l = ws + 32;
    float m_reg = -1e30f, l_reg = 0; f32x16 o[4] = {};
    const int vb0 = (int)(uintptr_t)V_lds + v_rd_base(lane);
#define RESC(a) do { if (__any((a) < 1.f)) { if (hi == 0) al_l[r32] = (a); asm volatile("s_waitcnt lgkmcnt(0)" ::: "memory");              \
                     _Pragma("unroll") for (int d_ = 0; d_ < 4; ++d_) _Pragma("unroll") for (int r = 0; r < 16; ++r) o[d_][r] *= al_l[crow(r, hi)]; } } while (0)
#define KBASE(t) ((j_lo + (t)) * KVBLK)
#define MASKT(P0_, P1_, t) do { const int kb_ = KBASE(t); if (kb_ + KVBLK - 1 > qlo || kb_ <= qlo + QBLK - 1 - W) mask_tile(P0_, P1_, qm - kb_, (unsigned)W); } while (0)
    constexpr int NQL = 8;
#define SEAM_K0() do { VMWN(NQL); SWRITE_HK(0); SBAR(); } while (0)
    f32x16 pA0, pA1, pB0, pB1; float mnA, mnB, alA, alB; bf16x8 pa0, pa1, pa2, pa3;
    SWRITE_HV(0); SBAR();
    if (NT > 1) SLOAD_H(cur, KBASE(1));
    SBAR(); qkt<0, HB>(pA0, pA1, lds, r32, hi, S.qr, KBASE(0));
    MASKT(pA0, pA1, 0); partialSM(pA0, pA1, m_reg, mnA, alA);
    if (NT > 1) { VMW(); SWRITE_H(1); KV_OUT(KBASE(1)); }
    __syncthreads();
#define HALF_STEP(PX0, PX1, mnX, alX, PY0, PY1, alY, t, KB, VB, SB) do {                                                      \
        SBAR(); qkt<KB, HB>(PX0, PX1, lds, r32, hi, S.qr, KBASE(t));                                             \
        finishSM(PY0, PY1, alY, l_reg, pa0, pa1, pa2, pa3); SBAR();                                                           \
        if ((t) + 1 < NT) { SLOAD_H(cur, KBASE((t) + 1)); SBAR(); }                                               \
        pv_tile<VB>(o, vb0, pa0, pa1, pa2, pa3); MASKT(PX0, PX1, (t)); partialSM(PX0, PX1, m_reg, mnX, alX);                                        \
        __syncthreads();                                                                                                      \
        if ((t) + 1 < NT) { VMW(); SWRITE_H(SB); KV_OUT(KBASE((t) + 1)); }                                                                          \
        RESC(alX); __syncthreads(); } while (0)
    for (int t = 1; t + 1 < NT; t += 2) {
        HALF_STEP(pB0, pB1, mnB, alB, pA0, pA1, alA, t, 1, 0, 0);
        HALF_STEP(pA0, pA1, mnA, alA, pB0, pB1, alB, t + 1, 0, 1, 1);
    }
    const bool even = (NT & 1) == 0;
    if (even) { SBAR(); qkt<1, HB>(pB0, pB1, lds, r32, hi, S.qr, KBASE(NT - 1)); SBAR(); }
    SLOAD_H(nxt, kbn); SBAR();
#pragma unroll
    for (int d0 = 0; d0 < 8; ++d0) S.qr[d0] = load8(nxt.Q + (size_t)(wid * QBLK + r32) * RSQ + d0 * 16 + hi * 8);
    SBAR();
    finishSM(pA0, pA1, alA, l_reg, pa0, pa1, pa2, pa3); SBAR();
    pv_tile<0>(o, vb0, pa0, pa1, pa2, pa3);
    if (even) { MASKT(pB0, pB1, NT - 1); partialSM(pB0, pB1, m_reg, mnB, alB); __syncthreads(); RESC(alB);
        finishSM(pB0, pB1, alB, l_reg, pa0, pa1, pa2, pa3); SBAR(); pv_tile<1>(o, vb0, pa0, pa1, pa2, pa3); }
    SBAR(); SEAM_K0();
    if (hi == 0) li_l[r32] = l_reg; asm volatile("s_waitcnt lgkmcnt(0)" ::: "memory");
    float rli[16];
#pragma unroll
    for (int r = 0; r < 16; ++r) rli[r] = __builtin_amdgcn_rcpf(li_l[crow(r, hi)]);
    bf16* Ow = cur.O + (size_t)(wid * QBLK) * RSQ;
    { constexpr int SW = 72; unsigned short* stg = (unsigned short*)(lds + ATT_LDS_BYTES) + wid * (32 * SW);
#pragma unroll
      for (int p = 0; p < 2; ++p) {
#pragma unroll
        for (int r = 0; r < 16; ++r) { const int orow = crow(r, hi);
#pragma unroll
            for (int dd = 0; dd < 2; ++dd) stg[orow * SW + dd * 32 + r32] = (unsigned short)(cvt_pk_bf16(o[2 * p + dd][r] * rli[r], 0.f) & 0xffffu); }
        asm volatile("s_waitcnt lgkmcnt(0)" ::: "memory");
#pragma unroll
        for (int i = 0; i < 4; ++i) { const int row = i * 8 + (lane >> 3), ch = lane & 7; const u32x4 v = *(const u32x4*)(stg + row * SW + ch * 8);
            *(u32x4*)(Ow + (size_t)row * RSQ + p * 64 + ch * 8) = v; }
        asm volatile("s_waitcnt lgkmcnt(0)" ::: "memory");
      } }
    __syncthreads();
#undef RESC
#undef KBASE
#undef MASKT
#undef SEAM_K0
#undef HALF_STEP
}
#undef ROW
#undef VMW
#undef VMWN
#undef SLOAD_H
#undef STG_IDX
#undef SWRITE_HK
#undef SWRITE_HV
#undef SWRITE_H
#undef KV_OUT
#undef BF8_TO_F32_STORE
#undef SBAR
#undef KSWZ
}

constexpr int SA_SP = 2096;
__device__ __forceinline__ void small_attn(char* lds, const bf16_t* Qp, int rsq, const float* cK, const float* cV, int cstride, int ncache,
                                           const float* nK, const float* nV, int nstride, int nnew, const float* lfc, const float* lfn, bf16_t* Op, int t_lo = 0, int t_hi = -1, float* part = nullptr) {
    const int tid = threadIdx.x, wid = __builtin_amdgcn_readfirstlane(tid >> 6), lane = tid & 63, fr = lane & 15, fq = lane >> 4;
    float* Sx = (float*)lds; float* Lr = Sx + 16 * SA_SP; float* Wt = Lr + 16; float* Bs = Wt + 16;
    const bool hb = lfc != nullptr;
    if (hb) {
        float l4[4]; float sm = 0.f;
#pragma unroll
        for (int i = 0; i < 4; ++i) { l4[i] = lfc[(size_t)(4 * tid + i) * NH]; sm += l4[i]; }
        float inc = sm;
#pragma unroll
        for (int o = 1; o < 64; o <<= 1) { const float t = __shfl_up(inc, o); if (lane >= o) inc += t; }
        if (lane == 63) Wt[wid] = inc;
        __syncthreads();
        float c = inc - sm;
        for (int w = 0; w < wid; ++w) c += Wt[w];
#pragma unroll
        for (int i = 0; i < 4; ++i) { c += l4[i]; Bs[4 * tid + i] = -c; }
        if (tid < nnew) { float t = 0.f; for (int w = 0; w < 8; ++w) t += Wt[w]; for (int k = 0; k <= tid; ++k) t += lfn[(size_t)k * NH]; Bs[ncache + tid] = -t; }
        __syncthreads();
    }
    const int nkeys = ncache + nnew, ntile = t_hi < 0 ? (nkeys >> 4) : t_hi; float* Mr = (float*)lds + 16 * SA_SP + 32 + 2080;
    bf16x8 qa[4];
#pragma unroll
    for (int ks = 0; ks < 4; ++ks) qa[ks] = *(const bf16x8*)(Qp + (size_t)fr * rsq + ks * 32 + fq * 8);
    for (int tile0 = t_lo + wid; tile0 < ntile; tile0 += 16) {
        f32x4 ka[2][8];
#pragma unroll
        for (int u = 0; u < 2; ++u) { int tile = tile0 + 8 * u; if (tile >= ntile) tile = tile0; const int key = tile * 16 + fr;
            const float* kp = key < ncache ? cK + (size_t)key * cstride : nK + (size_t)(key - ncache) * nstride;
#pragma unroll
            for (int ks = 0; ks < 4; ++ks) { ka[u][2 * ks] = *(const f32x4*)(kp + ks * 32 + fq * 8); ka[u][2 * ks + 1] = *(const f32x4*)(kp + ks * 32 + fq * 8 + 4); } }
#pragma unroll
        for (int u = 0; u < 2; ++u) { const int tile = tile0 + 8 * u; if (tile < ntile) { const int key = tile * 16 + fr;
            f32x4 acc = {0.f, 0.f, 0.f, 0.f};
#pragma unroll
            for (int ks = 0; ks < 4; ++ks) { const u32x4 w = pack8f(ka[u][2 * ks], ka[u][2 * ks + 1]); acc = __builtin_amdgcn_mfma_f32_16x16x32_bf16(qa[ks], *reinterpret_cast<const bf16x8*>(&w), acc, 0, 0, 0); }
            const float bs = hb ? Bs[key] : 0.f;
#pragma unroll
            for (int r = 0; r < 4; ++r) { const int q = fq * 4 + r; float sc = acc[r] * SM_SCALE + bs;
                if (key >= ncache && (key - ncache) > q) sc = -__builtin_inff();
                Sx[q * SA_SP + key] = sc; } } }
    }
    __syncthreads();
#pragma unroll
    for (int qq = 0; qq < 2; ++qq) { const int q = wid * 2 + qq; float* row = Sx + q * SA_SP; const int k_lo = 16 * t_lo, k_hi = 16 * ntile;
        float m = -__builtin_inff();
        for (int k = k_lo + lane; k < k_hi; k += 64) m = fmaxf(m, row[k]);
        m = wave_max(m); float s = 0.f;
        for (int k = k_lo + lane; k < k_hi; k += 64) { const float p = __expf(row[k] - m); row[k] = p; s += p; }
        s = wave_sum(s); if (lane == 0) { Lr[q] = s; Mr[q] = m; } }
    __syncthreads();
    f32x2 o[16];
#pragma unroll
    for (int q = 0; q < 16; ++q) o[q] = (f32x2){0.f, 0.f};
    for (int tile = t_lo + wid; tile < ntile; tile += 8) {
        f32x2 vv[16];
#pragma unroll
        for (int kk = 0; kk < 16; ++kk) { const int key = tile * 16 + kk;
            const float* vp = key < ncache ? cV + (size_t)key * cstride : nV + (size_t)(key - ncache) * nstride;
            vv[kk] = *(const f32x2*)(vp + 2 * lane); }
#pragma unroll
        for (int kk = 0; kk < 16; ++kk) { const int key = tile * 16 + kk;
#pragma unroll
            for (int q = 0; q < 16; ++q) { const float p = Sx[q * SA_SP + key]; o[q] += vv[kk] * p; } }
    }
    __syncthreads();
    float* Pp = Sx;
#pragma unroll
    for (int q = 0; q < 16; ++q) *(f32x2*)(Pp + (wid * 16 + q) * 128 + 2 * lane) = o[q];
    __syncthreads();
    { const int q = tid >> 5, d4 = (tid & 31) * 4; f32x4 s = {0.f, 0.f, 0.f, 0.f};
#pragma unroll
      for (int w = 0; w < 8; ++w) s += *(const f32x4*)(Pp + (w * 16 + q) * 128 + d4);
      if (part) { *(f32x4*)(part + q * 128 + d4) = s; if (d4 == 0) { part[2048 + q] = Mr[q]; part[2064 + q] = Lr[q]; } }
      else { const float rl = 1.f / Lr[q]; s = s * rl;
      u32x2 w2; w2.x = cvt_pk_bf16(s[0], s[1]); w2.y = cvt_pk_bf16(s[2], s[3]);
      *(u32x2*)(Op + (size_t)q * rsq + d4) = w2; } }
    __syncthreads();
}


#define XB_TMO      128
#define XB_XCNT(j)  (256  + 64 * (j))
#define XB_XSUB(j)  (1280 + 64 * (j))
#define XB_XGEN(j)  (2304 + 64 * (j))
#define XB_TOP      3328
#define XB_TOPGEN   3392
#define XCD_BAR_WORDS 3456
#define XB_SPIN_CAP (1u << 22)
__device__ __forceinline__ unsigned xb_ld(unsigned* p)              { return __hip_atomic_load(p, __ATOMIC_RELAXED, __HIP_MEMORY_SCOPE_AGENT); }
__device__ __forceinline__ unsigned xb_add(unsigned* p, unsigned v) { return __hip_atomic_fetch_add(p, v, __ATOMIC_RELAXED, __HIP_MEMORY_SCOPE_AGENT); }
__device__ __forceinline__ unsigned xb_xcc_id() { return (unsigned)__builtin_amdgcn_s_getreg((3 << 11) | 20) & 0xFu; }
#define XB_SPIN(cond, bar) do { unsigned _sp = 0; while (cond) { __builtin_amdgcn_s_sleep(1); \
    if ((++_sp & 255u) == 0u) { if (xb_ld(&(bar)[XB_TMO])) break; if (_sp > XB_SPIN_CAP) { atomicAdd(&(bar)[XB_TMO], 1u); break; } } } } while (0)
struct XcdBarrier { unsigned* bar; unsigned x; volatile LAS unsigned* st; };
__device__ __forceinline__ XcdBarrier xcd_barrier_post(unsigned* bar, volatile LAS unsigned* st) {
    XcdBarrier b; b.bar = bar; b.x = xb_xcc_id(); b.st = st;
    if (threadIdx.x == 0) (void)xb_add(&bar[XB_XCNT(b.x)], 1u);
    return b;
}
__device__ __forceinline__ void xcd_barrier_complete(unsigned* bar, unsigned x, unsigned& nloc, unsigned& nx) {
    const unsigned G = gridDim.x * gridDim.y * gridDim.z;
    unsigned sum, cnt, mine, sp = 0u;
    for (;;) {
        sum = 0u; cnt = 0u; mine = 0u;
#pragma unroll
        for (unsigned j = 0; j < 16; ++j) { const unsigned c = xb_ld(&bar[XB_XCNT(j)]); sum += c; cnt += (c > 0u) ? 1u : 0u; mine = (j == x) ? c : mine; }
        if (sum == G) break;
        __builtin_amdgcn_s_sleep(1);
        if ((++sp & 255u) == 0u) { if (xb_ld(&bar[XB_TMO])) break; if (sp > XB_SPIN_CAP) { atomicAdd(&bar[XB_TMO], 1u); break; } }
    }
    nloc = mine > 0u ? mine : 1u; nx = cnt > 0u ? cnt : 1u;
}
__device__ __forceinline__ void xcd_barrier(const XcdBarrier& b) {
    asm volatile("s_waitcnt vmcnt(0)" ::: "memory");
    __syncthreads();
    if (threadIdx.x == 0) {
        unsigned* bar = b.bar;
        __builtin_amdgcn_s_waitcnt(0);
        unsigned nloc = b.st[0], nx = b.st[1];
        if (nloc == 0u) { xcd_barrier_complete(bar, b.x, nloc, nx); b.st[0] = nloc; b.st[1] = nx; }
        const unsigned old = xb_add(&bar[XB_XSUB(b.x)], 1u);
        const unsigned gen = old / nloc;
        if (old + 1u == (gen + 1u) * nloc) {
            __builtin_amdgcn_fence(__ATOMIC_RELEASE, "agent");
            asm volatile("s_waitcnt vmcnt(0)" ::: "memory");
            const unsigned og = xb_add(&bar[XB_TOP], 1u);
            const unsigned tg = og / nx;
            if (og + 1u == (tg + 1u) * nx) xb_add(&bar[XB_TOPGEN], 1u);
            else XB_SPIN(xb_ld(&bar[XB_TOPGEN]) == tg, bar);
            __builtin_amdgcn_fence(__ATOMIC_ACQUIRE, "agent");
            xb_add(&bar[XB_XGEN(b.x)], 1u);
            asm volatile("s_waitcnt vmcnt(0)" ::: "memory");
        } else {
            XB_SPIN(xb_ld(&bar[XB_XGEN(b.x)]) == gen, bar);
            __builtin_amdgcn_fence(__ATOMIC_ACQUIRE, "agent");
            asm volatile("s_waitcnt vmcnt(0)" ::: "memory");
        }
    }
    __syncthreads();
}


__device__ __forceinline__ unsigned short f2bf_rne(float x) { return (unsigned short)(cvt_pk_bf16(x, 0.f) & 0xffffu); }
template <class BRow, class EpiFn>
__device__ __forceinline__ void sgemm(char* lds, const bf16_t* A, int lda, int K, int ncg, int vcu, int G, const bf16_t* Bt, int ldb, BRow brow, EpiFn epi) {
    const int tid = threadIdx.x, lane = tid & 63, wave = __builtin_amdgcn_readfirstlane(tid >> 6), fr = lane & 15, fq = lane >> 4;
    asm volatile("" : "+s"(K));
    const int nst = K / 256;
    f32x4* red = (f32x4*)lds;
    for (int job = vcu; job < ncg * 4; job += G) {
        const int rg = job & 3, cg = job >> 2;
        const bf16_t* ap = A + (size_t)(32 * rg + fr) * lda + fq * 8 + wave * 32;
        const bf16_t* bp0 = Bt + (size_t)brow(cg, 0, fr) * ldb + fq * 8 + wave * 32;
        const bf16_t* bp1 = Bt + (size_t)brow(cg, 1, fr) * ldb + fq * 8 + wave * 32;
        const size_t a16 = (size_t)16 * lda;
        f32x4 acc[2][2];
#pragma unroll
        for (int i = 0; i < 2; ++i)
#pragma unroll
            for (int j = 0; j < 2; ++j) acc[i][j] = (f32x4){0.f, 0.f, 0.f, 0.f};
        bf16x8 x0[4], x1[4];
#define SG_LOAD(x, st) do { const int ko_ = (st) * 256; x[0] = *(const bf16x8*)(ap + ko_); x[1] = *(const bf16x8*)(ap + a16 + ko_); x[2] = *(const bf16x8*)(bp0 + ko_); x[3] = *(const bf16x8*)(bp1 + ko_); } while (0)
#define SG_MMA(x) do { acc[0][0] = __builtin_amdgcn_mfma_f32_16x16x32_bf16(x[0], x[2], acc[0][0], 0, 0, 0); acc[0][1] = __builtin_amdgcn_mfma_f32_16x16x32_bf16(x[0], x[3], acc[0][1], 0, 0, 0); \
                         acc[1][0] = __builtin_amdgcn_mfma_f32_16x16x32_bf16(x[1], x[2], acc[1][0], 0, 0, 0); acc[1][1] = __builtin_amdgcn_mfma_f32_16x16x32_bf16(x[1], x[3], acc[1][1], 0, 0, 0); } while (0)
        bf16x8 y0[4], y1[4];
        SG_LOAD(x0, 0); SG_LOAD(x1, 1);
#pragma unroll 1
        for (int st = 0; st < nst; st += 4) {
            if (st + 2 < nst) { SG_LOAD(y0, st + 2); SG_LOAD(y1, st + 3); }
            SG_MMA(x0); SG_MMA(x1);
            if (st + 4 < nst) { SG_LOAD(x0, st + 4); SG_LOAD(x1, st + 5); }
            if (st + 2 < nst) { SG_MMA(y0); SG_MMA(y1); }
        }
#undef SG_LOAD
#undef SG_MMA
#pragma unroll
        for (int i = 0; i < 2; ++i)
#pragma unroll
            for (int j = 0; j < 2; ++j) red[(wave * 4 + i * 2 + j) * 64 + lane] = acc[i][j];
        __syncthreads();
        if (wave < 4) { f32x4 sum = red[wave * 64 + lane];
#pragma unroll
            for (int w = 1; w < 8; ++w) sum += red[(w * 4 + wave) * 64 + lane];
            epi(cg, wave & 1, 32 * rg + 16 * (wave >> 1) + 4 * fq, fr, lane, sum); }
        __syncthreads();
    }
}
__device__ __forceinline__ void sgemm_res(char* lds, const bf16_t* A, int lda, int K, int vcu, int G, const bf16_t* Bt, int ldb, bf16_t* XB, float* ss_out) {
    sgemm(lds, A, lda, K, DM / 32, vcu, G, Bt, ldb, [](int cg, int j, int fr) { return 32 * cg + 16 * j + fr; },
          [=](int cg, int j, int r0, int fr, int lane, f32x4 acc) {
#pragma unroll
              for (int r = 0; r < 4; ++r) { const int row = MP + r0 + r; bf16_t* px = XB + (size_t)row * DM + 32 * cg + 16 * j + fr;
                  const float x = bf2f(*px) + acc[r]; *px = f2bf_rne(x); float sq = x * x;
                  sq += __shfl_xor(sq, 1); sq += __shfl_xor(sq, 2); sq += __shfl_xor(sq, 4); sq += __shfl_xor(sq, 8);
                  if (fr == 0) __hip_atomic_fetch_add(ss_out + row, sq, __ATOMIC_RELAXED, __HIP_MEMORY_SCOPE_AGENT); } });
}

__device__ __forceinline__ float lru_step(float h, float la, float g) {
    const float a = __expf(la), e = 2.f * la;
    const float ser = -e * (1.f + e * (0.5f + e * (0.16666667f + e * 0.041666668f)));
    const float om = e > -0.125f ? ser : 1.f - a * a;
    return a * h + __builtin_amdgcn_sqrtf(fmaxf(om, 0.f)) * g;
}

template <int MAP> __device__ __forceinline__ int rowmap(int n) {
    if (MAP == 1) { const int up = n >= DFF ? 1 : 0; const int c = up ? n - DFF : n; return (c >> 7) * 256 + up * 128 + (c & 127); }
    if (MAP == 2) return (n >> 7) * 256 + (n & 127);
    if (MAP == 3) return (n >> 7) * 256 + 128 + (n & 127);
    return n;
}
template <int MAP> __device__ __forceinline__ void tr_item(const float* W, int ldw, int nvalid, const float* gain, bf16_t* WT, int ldwt, int nblk, LAS float* scr, int item, int lane) {
    const int kb = item / nblk, nb = item % nblk, k0 = 64 * kb, n0 = 32 * nb;
    const int n = n0 + (lane & 31);
    float tv[32];
#pragma unroll
    for (int i = 0; i < 32; ++i) { const int kk = 2 * i + (lane >> 5); tv[i] = (n < nvalid) ? __builtin_nontemporal_load(&W[(size_t)(k0 + kk) * ldw + n]) : 0.f; }
    if (gain) {
#pragma unroll
        for (int i = 0; i < 32; ++i) tv[i] *= gain[k0 + 2 * i + (lane >> 5)]; }
#pragma unroll
    for (int i = 0; i < 32; ++i) scr[(2 * i + (lane >> 5)) * 33 + (lane & 31)] = tv[i];
    LDS_WAIT(); asm volatile("" ::: "memory");
    const int c = lane & 7; const int r0 = rowmap<MAP>(n0);
#pragma unroll
    for (int j = 0; j < 4; ++j) { const int nn = (lane >> 3) + 8 * j; const LAS float* s = scr + (8 * c) * 33 + nn;
        u32x4 o; o.x = cvt_pk_bf16(s[0 * 33], s[1 * 33]); o.y = cvt_pk_bf16(s[2 * 33], s[3 * 33]); o.z = cvt_pk_bf16(s[4 * 33], s[5 * 33]); o.w = cvt_pk_bf16(s[6 * 33], s[7 * 33]);
        *(u32x4*)(WT + (size_t)(r0 + nn) * ldwt + k0 + 8 * c) = o; }
    LDS_WAIT(); asm volatile("" ::: "memory");
}

struct Args { const float* in[32]; float* out; unsigned char* ws; int ph_lo, ph_hi; };

__device__ __forceinline__ att::BlockRef fox_ref(int vcu, int G, int idx, bf16_t* Qb, bf16_t* Kb, bf16_t* Vb, bf16_t* Ob, const float* biasP, float* fout) {
    const int k = idx >> 1, pass = idx & 1, L = vcu + k * G, bh = L >> 3, x = L & 7, qb = pass ? 15 - x : x, b = bh >> 4, h = bh & 15;
    att::BlockRef r;
    r.Q = (const att::bf16*)(Qb + ((size_t)(b * SEQ + qb * 256)) * DM + h * HD); r.O = (att::bf16*)(Ob + ((size_t)(b * SEQ + qb * 256)) * DM + h * HD);
    r.K = (const att::bf16*)(Kb + (size_t)b * SEQ * DM + h * HD); r.V = (const att::bf16*)(Vb + (size_t)b * SEQ * DM + h * HD);
    r.cb = biasP + (size_t)bh * SEQ; r.fk = fout + O_PK + (size_t)b * SEQ * DM + h * HD; r.fv = fout + O_PV + (size_t)b * SEQ * DM + h * HD; r.P0 = qb * 256; return r;
}
__device__ __forceinline__ att::BlockRef xat_ref(int vcu, int G, int idx, bf16_t* Q2, const bf16_t* MK, const bf16_t* MVv, int layer) {
    const int L = vcu + idx * G, pm = L >> 2, h = L & 3, b = pm >> 4;
    att::BlockRef r;
    r.Q = (const att::bf16*)(Q2 + (size_t)pm * 256 * MEMW + h * HD); r.O = (att::bf16*)(Q2 + (size_t)pm * 256 * MEMW + h * HD);
    r.K = (const att::bf16*)(MK + ((size_t)(layer * 2048 + b * 256)) * MEMW + h * HD); r.V = (const att::bf16*)(MVv + ((size_t)(layer * 2048 + b * 256)) * MEMW + h * HD);
    r.cb = nullptr; r.fk = nullptr; r.fv = nullptr; r.P0 = 256; return r;
}

__global__ void __launch_bounds__(512, 2) mk_fwd(Args a) {
    extern __shared__ __attribute__((aligned(16))) unsigned char lds[];
    cg::grid_group grid = cg::this_grid();
    const int tid = threadIdx.x, lane = tid & 63, wave = __builtin_amdgcn_readfirstlane(tid >> 6);
    const int G = gridDim.x, bx = blockIdx.x; const int vcu = (G % 8 == 0) ? (bx % 8) * (G / 8) + bx / 8 : bx;
    const int gw = vcu * 8 + wave, NGW = G * 8, gt = vcu * 512 + tid, GT = G * 512;
    unsigned char* ws = a.ws; float* out = a.out;
    bf16_t* WFIN = (bf16_t*)(ws + WS_WFIN); bf16_t* WFOUT = (bf16_t*)(ws + WS_WFOUT); bf16_t* WLIN = (bf16_t*)(ws + WS_WLIN); bf16_t* WGATE = (bf16_t*)(ws + WS_WGATE);
    bf16_t* WLOUT = (bf16_t*)(ws + WS_WLOUT); bf16_t* WXQ = (bf16_t*)(ws + WS_WXQ); bf16_t* WXKV = (bf16_t*)(ws + WS_WXKV); bf16_t* WXO = (bf16_t*)(ws + WS_WXO);
    bf16_t* WFFI = (bf16_t*)(ws + WS_WFFI); bf16_t* WFFO = (bf16_t*)(ws + WS_WFFO);
    bf16_t* XB = (bf16_t*)(ws + WS_XB); bf16_t* Qb = (bf16_t*)(ws + WS_BIG); bf16_t* Kb = (bf16_t*)(ws + WS_BIG + ACT_B); bf16_t* Vb = (bf16_t*)(ws + WS_BIG + 2 * ACT_B); bf16_t* X4 = (bf16_t*)(ws + WS_BIG + 3 * ACT_B);
    bf16_t* Hb = Qb; bf16_t* Gb = Qb; bf16_t* Ub = Kb; bf16_t* LAb = Kb; bf16_t* UCb = Vb; bf16_t* BBb = X4;
    bf16_t* Q2 = (bf16_t*)(ws + WS_Q2); bf16_t* MEMN = (bf16_t*)(ws + WS_MEMN); bf16_t* MEMK = (bf16_t*)(ws + WS_MEMK); bf16_t* MEMV = (bf16_t*)(ws + WS_MEMV);
    float* SS = (float*)(ws + WS_SS); float* biasP = (float*)(ws + WS_BIASP); float* biasS = (float*)(ws + WS_BIASS);
    float* CA = (float*)(ws + WS_CA); float* CBv = (float*)(ws + WS_CB); float* SPL = (float*)(ws + WS_SPL);
    PG8_LAS unsigned char* lds3 = (PG8_LAS unsigned char*)lds;
    const int lo = a.ph_lo, hi = a.ph_hi;
#ifndef SKIPMASK
#define SKIPMASK 0u
#endif
#define IN(k) (lo <= (k) && (k) < hi && !((SKIPMASK >> (k)) & 1u))
    unsigned* barw = (unsigned*)(ws + WS_BAR);
    volatile LAS unsigned* bst = (volatile LAS unsigned*)(lds3 + 143360);
    if (tid < 2) bst[tid] = 0u;
    __syncthreads();
    XcdBarrier xbar; xbar.bar = barw; xbar.x = 0; xbar.st = bst;
    if (hi - lo > 1) xbar = xcd_barrier_post(barw, bst);
    if (lo < 0) grid.sync();
#define SEAM(k) do { if (IN(k) && IN((k) + 1)) xcd_barrier(xbar); } while (0)
    constexpr int NOB = 1 << 30;

    if (IN(0)) {
        for (int i = gt; i < 6 * MR; i += GT) SS[MR + i] = 0.f;
        for (int i = gt; i < DM; i += GT) { const float x = -a.in[25][i]; SPL[i] = 8.f * (fmaxf(x, 0.f) + log1pf(__expf(-fabsf(x)))); }
        for (int r0 = gw; r0 < MR; r0 += 2 * NGW) {
            f32x4 v[2][8];
#pragma unroll
            for (int q = 0; q < 2; ++q) { const int r = r0 + q * NGW;
                if (r < MV) { const float* src = r < MP ? a.in[0] + (size_t)r * DM : a.in[1] + (size_t)(r - MP) * DM; const f32x4* xr = (const f32x4*)src + lane;
#pragma unroll
                    for (int j = 0; j < 8; ++j) v[q][j] = __builtin_nontemporal_load(&xr[64 * j]); }
                else {
#pragma unroll
                    for (int j = 0; j < 8; ++j) v[q][j] = (f32x4){0.f, 0.f, 0.f, 0.f}; } }
#pragma unroll
            for (int q = 0; q < 2; ++q) { const int r = r0 + q * NGW;
                if (r < MR) { float s = 0.f;
#pragma unroll
                    for (int j = 0; j < 8; ++j) s += (v[q][j][0] * v[q][j][0] + v[q][j][1] * v[q][j][1]) + (v[q][j][2] * v[q][j][2] + v[q][j][3] * v[q][j][3]);
                    s = wave_sum(s); if (lane == 0) SS[r] = s;
                    u32x2* o8 = (u32x2*)(XB + (size_t)r * DM) + lane;
#pragma unroll
                    for (int j = 0; j < 8; ++j) { u32x2 w; w.x = cvt_pk_bf16(v[q][j][0], v[q][j][1]); w.y = cvt_pk_bf16(v[q][j][2], v[q][j][3]); o8[64 * j] = w; } } }
        }
        for (int r = gw; r < 4096; r += NGW) { const int layer = r >> 11, row = r & 2047;
            const f32x4* xr = (const f32x4*)(a.in[2] + (size_t)row * DM) + lane; const f32x4* gr = (const f32x4*)(a.in[11] + (size_t)layer * DM) + lane;
            f32x4 v[8]; float s = 0.f;
#pragma unroll
            for (int j = 0; j < 8; ++j) { v[j] = xr[64 * j]; s += (v[j][0] * v[j][0] + v[j][1] * v[j][1]) + (v[j][2] * v[j][2] + v[j][3] * v[j][3]); }
            const float rs = __builtin_amdgcn_rsqf(wave_sum(s) * (1.f / DM) + EPS);
            u32x2* o8 = (u32x2*)(MEMN + (size_t)r * DM) + lane;
#pragma unroll
            for (int j = 0; j < 8; ++j) { const f32x4 g4 = gr[64 * j]; u32x2 w; w.x = cvt_pk_bf16(v[j][0] * rs * g4[0], v[j][1] * rs * g4[1]); w.y = cvt_pk_bf16(v[j][2] * rs * g4[2], v[j][3] * rs * g4[3]); o8[64 * j] = w; }
        }
        LAS float* scr = (LAS float*)(lds3) + wave * (64 * 33 + 16);
        int base = 0;
#define TR_JOB(MAP, W, ldw, nvalid, gain, WT, ldwt, K, Npad) do { const int nblk_ = (Npad) / 32, nit_ = ((K) / 64) * nblk_; int st_ = (gw - base) % NGW; if (st_ < 0) st_ += NGW; \
        for (int it_ = st_; it_ < nit_; it_ += NGW) tr_item<MAP>(W, ldw, nvalid, gain, WT, ldwt, nblk_, scr, it_, lane); base = (base + nit_) % NGW; } while (0)
        TR_JOB(0, a.in[15], NFIN, NFIN, a.in[10], WFIN, DM, DM, NFIN_PAD);
        TR_JOB(0, a.in[17], DM, DM, (const float*)nullptr, WFOUT, DM, DM, DM);
        TR_JOB(0, a.in[18], 2 * DM, 2 * DM, a.in[10] + DM, WLIN, DM, DM, 2 * DM);
        for (int blk = 0; blk < 8; ++blk) {
            TR_JOB(2, a.in[21] + (size_t)blk * 65536, 256, 256, (const float*)nullptr, WGATE + (size_t)blk * 2 * 65536, 256, 256, 256);
            TR_JOB(3, a.in[23] + (size_t)blk * 65536, 256, 256, (const float*)nullptr, WGATE + (size_t)blk * 2 * 65536, 256, 256, 256);
        }
        TR_JOB(0, a.in[26], DM, DM, (const float*)nullptr, WLOUT, DM, DM, DM);
        for (int i = 0; i < 2; ++i) {
            TR_JOB(0, a.in[27] + (size_t)i * DM * MEMW, MEMW, MEMW, a.in[12] + (size_t)i * DM, WXQ + (size_t)i * MEMW * DM, DM, DM, MEMW);
            TR_JOB(0, a.in[28] + (size_t)i * DM * 2 * MEMW, 2 * MEMW, 2 * MEMW, (const float*)nullptr, WXKV + (size_t)i * 2 * MEMW * DM, DM, DM, 2 * MEMW);
            TR_JOB(0, a.in[29] + (size_t)i * MEMW * DM, DM, DM, (const float*)nullptr, WXO + (size_t)i * DM * MEMW, MEMW, MEMW, DM);
            TR_JOB(1, a.in[30] + (size_t)i * DM * 2 * DFF, 2 * DFF, 2 * DFF, a.in[13] + (size_t)i * DM, WFFI + (size_t)i * 2 * DFF * DM, DM, DM, 2 * DFF);
            TR_JOB(0, a.in[31] + (size_t)i * DFF * DM, DM, DM, (const float*)nullptr, WFFO + (size_t)i * DM * DFF, DFF, DFF, DM);
        }
#undef TR_JOB
        __syncthreads();
    }
    SEAM(0);

    if (IN(1)) {
        { pg8::Gemm g{XB, WFIN, DM, DM, DM, 0, NOB, 0, 128}; pg8::StaticOrder S; S.init(NTM, 25, G, bx);
          pg8::EpiFoxIn E{SS, Qb, Kb, Vb, out, a.in[16]}; pg8::gemm_phase(lds3, g, S, E); }
        { pg8::Gemm g{MEMN, WXKV, DM, DM, DM, 0, 8, 2 * MEMW, -1}; pg8::StaticOrder S; S.init(16, 4, G, G - 1 - bx);
          pg8::EpiMemKV E{out, MEMK, MEMV}; pg8::gemm_phase(lds3, g, S, E); }
    }
    SEAM(1);

    if (IN(2)) {
        float* PART = (float*)(ws + WS_BIASS);
        for (int u = vcu; u < 256; u += G) {
            { const int bh = u >> 1, half = u & 1, b = bh >> 4, h = bh & 15;
                small_attn((char*)lds, Qb + (size_t)(MP + b * DSQ) * DM + h * HD, DM, a.in[3] + ((size_t)b * PAST * NH + h) * HD, a.in[4] + ((size_t)b * PAST * NH + h) * HD, NH * HD, PAST,
                           out + O_SK + (size_t)(b * DSQ) * DM + h * HD, out + O_SV + (size_t)(b * DSQ) * DM + h * HD, DM, DSQ,
                           a.in[5] + (size_t)b * PAST * NH + h, out + O_SLF + (size_t)(b * DSQ) * NH + h, (bf16_t*)nullptr, half ? 65 : 0, half ? 129 : 65, PART + (size_t)u * BIASS_LD); }
            if (u & 1) { const int q = u >> 1, b = q >> 4, h = q & 15;
                const float* lf = out + O_PLF + (size_t)b * SEQ * NH + h; float* Wt = (float*)lds; float l8[8]; float sm = 0.f;
#pragma unroll
                for (int i = 0; i < 8; ++i) { l8[i] = lf[(size_t)(8 * tid + i) * NH]; sm += l8[i]; }
                float inc = sm;
#pragma unroll
                for (int o = 1; o < 64; o <<= 1) { const float t = __shfl_up(inc, o); if (lane >= o) inc += t; }
                if (lane == 63) Wt[wave] = inc;
                __syncthreads();
                float c = inc - sm;
                for (int w = 0; w < wave; ++w) c += Wt[w];
                float* bp = biasP + (size_t)q * SEQ + 8 * tid; f32x4 o0, o1;
#pragma unroll
                for (int i = 0; i < 4; ++i) { c += l8[i]; o0[i] = -c * INV_SCALE; }
#pragma unroll
                for (int i = 0; i < 4; ++i) { c += l8[4 + i]; o1[i] = -c * INV_SCALE; }
                *(f32x4*)bp = o0; *(f32x4*)(bp + 4) = o1;
                __syncthreads();
            }
        }
    }
    SEAM(2);

    if (IN(3)) {
        for (int u = vcu; u < 128; u += G) { const int b = u >> 4, h = u & 15, q = tid >> 5, d4 = (tid & 31) * 4;
            const float* p0 = (const float*)(ws + WS_BIASS) + (size_t)(2 * u) * BIASS_LD; const float* p1 = p0 + BIASS_LD;
            const float m0 = p0[2048 + q], m1 = p1[2048 + q], m = fmaxf(m0, m1), w0 = __expf(m0 - m), w1 = __expf(m1 - m);
            const float rl = 1.f / (p0[2064 + q] * w0 + p1[2064 + q] * w1);
            const f32x4 v = (*(const f32x4*)(p0 + q * 128 + d4) * w0 + *(const f32x4*)(p1 + q * 128 + d4) * w1) * rl;
            u32x2 w2; w2.x = cvt_pk_bf16(v[0], v[1]); w2.y = cvt_pk_bf16(v[2], v[3]);
            *(u32x2*)(X4 + (size_t)(MP + b * DSQ + q) * DM + h * HD + d4) = w2; }
        const int nitems = vcu < 1024 ? (1024 - vcu + G - 1) / G : 0, nblk = 2 * nitems;
        if (nblk > 0) { att::Seam S; att::BlockRef cur = fox_ref(vcu, G, 0, Qb, Kb, Vb, X4, biasP, out);
            att::att_prime<DM, DM, true>(cur, NOB, (char*)lds, S);
            for (int i = 0; i < nblk; ++i) { const att::BlockRef nxt = (i + 1 < nblk) ? fox_ref(vcu, G, i + 1, Qb, Kb, Vb, X4, biasP, out) : cur;
                if ((i & 1) == 0) { for (int k = tid * 4; k < SEQ; k += 2048) *(f32x4*)(lds + att::LDS_BIAS + k * 4) = *(const f32x4*)(cur.cb + k); __syncthreads(); }
                att::att_block<DM, DM, true>(cur, nxt, SEQ, NOB, (char*)lds, S); cur = nxt; } }
    }
    SEAM(3);

    if (IN(4)) { pg8::Gemm g{X4, WFOUT, DM, DM, DM, 0, NOB, 0, 128}; pg8::StaticOrder S; S.init(128, 8, G, bx);
        pg8::EpiRes E{XB, SS + 1 * MR}; pg8::gemm_phase(lds3, g, S, E);
        sgemm_res((char*)lds, X4 + (size_t)MP * DM, DM, DM, vcu, G, WFOUT, DM, XB, SS + 1 * MR); }
    SEAM(4);

#define XATTN_FFN(i, pb, ssA, ssB, ssC) do { \
    if (IN(pb)) { pg8::Gemm g{XB, WXQ + (size_t)(i) * MEMW * DM, DM, DM, DM, 0, NOB, 0, 128}; pg8::StaticOrder S; S.init(128, 2, G, bx); \
        pg8::EpiScale E{SS + (ssA) * MR, Q2, MEMW}; pg8::gemm_phase(lds3, g, S, E); \
        { const float* ssp = SS + (ssA) * MR; bf16_t* q2 = Q2; \
          sgemm((char*)lds, XB + (size_t)MP * DM, DM, DM, MEMW / 32, G - 1 - vcu, G, WXQ + (size_t)(i) * MEMW * DM, DM, [](int cg, int j, int fr) { return 32 * cg + 16 * j + fr; }, \
              [=](int cg, int j, int r0, int fr, int lane, f32x4 acc) { _Pragma("unroll") for (int r = 0; r < 4; ++r) { const int row = MP + r0 + r; \
                  q2[(size_t)row * MEMW + 32 * cg + 16 * j + fr] = f2bf_rne(acc[r] * pg8::rstd_of(ssp, row)); } }); } } \
    SEAM(pb); \
    if (IN((pb) + 1)) { \
        for (int u = G - 1 - vcu; u < 32; u += G) { const int b = u >> 2, h = u & 3; bf16_t* qp = Q2 + (size_t)(MP + b * DSQ) * MEMW + h * HD; \
            small_attn((char*)lds, qp, MEMW, a.in[6] + (((size_t)((i) * NB + b) * NMEM) * 4 + h) * HD, a.in[7] + (((size_t)((i) * NB + b) * NMEM) * 4 + h) * HD, MEMW, NMEM, \
                       (const float*)nullptr, (const float*)nullptr, 0, 0, (const float*)nullptr, (const float*)nullptr, qp); } \
        const int nblk = vcu < 512 ? (512 - vcu + G - 1) / G : 0; \
        if (nblk > 0) { att::Seam S; att::BlockRef cur = xat_ref(vcu, G, 0, Q2, MEMK, MEMV, (i)); \
            att::att_prime<MEMW, MEMW, false>(cur, NOB, (char*)lds, S); \
            for (int k = 0; k < nblk; ++k) { const att::BlockRef nxt = (k + 1 < nblk) ? xat_ref(vcu, G, k + 1, Q2, MEMK, MEMV, (i)) : cur; \
                att::att_block<MEMW, MEMW, false>(cur, nxt, NMEM, NOB, (char*)lds, S); cur = nxt; } } } \
    SEAM((pb) + 1); \
    if (IN((pb) + 2)) { pg8::Gemm g{Q2, WXO + (size_t)(i) * DM * MEMW, MEMW, MEMW, MEMW, 0, NOB, 0, 128}; pg8::StaticOrder S; S.init(128, 8, G, bx); \
        pg8::EpiRes E{XB, SS + (ssB) * MR}; pg8::gemm_phase(lds3, g, S, E); \
        sgemm_res((char*)lds, Q2 + (size_t)MP * MEMW, MEMW, MEMW, vcu, G, WXO + (size_t)(i) * DM * MEMW, MEMW, XB, SS + (ssB) * MR); } \
    SEAM((pb) + 2); \
    if (IN((pb) + 3)) { pg8::Gemm g{XB, WFFI + (size_t)(i) * 2 * DFF * DM, DM, DM, DM, 0, NOB, 0, 128}; pg8::StaticOrder S; S.init(NTM, 44, G, bx); \
        pg8::EpiSwiglu E{SS + (ssB) * MR, Hb}; pg8::gemm_phase(lds3, g, S, E); } \
    SEAM((pb) + 3); \
    if (IN((pb) + 4)) { pg8::Gemm g{Hb, WFFO + (size_t)(i) * DM * DFF, DFF, DFF, DFF, 0, NOB, 0, 128}; pg8::StaticOrder S; S.init(128, 8, G, bx); \
        pg8::EpiRes E{XB, SS + (ssC) * MR}; pg8::gemm_phase(lds3, g, S, E); \
        sgemm_res((char*)lds, Hb + (size_t)MP * DFF, DFF, DFF, vcu, G, WFFO + (size_t)(i) * DM * DFF, DFF, XB, SS + (ssC) * MR); } \
    SEAM((pb) + 4); } while (0)

    XATTN_FFN(0, 5, 1, 2, 3);

    if (IN(10)) { pg8::Gemm g{XB, WLIN, DM, DM, DM, 0, NOB, 0, 128}; pg8::StaticOrder S; S.init(128, 16, G, bx);
        pg8::EpiLruIn E{SS + 3 * MR, Gb, Ub, out}; pg8::gemm_phase(lds3, g, S, E);
        { const float* ssp = SS + 3 * MR; bf16_t* gb = Gb; bf16_t* ub = Ub; float* o = out;
          sgemm((char*)lds, XB + (size_t)MP * DM, DM, DM, 2 * DM / 32, vcu, G, WLIN, DM, [](int cg, int j, int fr) { return 32 * cg + 16 * j + fr; },
              [=](int cg, int j, int r0, int fr, int lane, f32x4 acc) {
#pragma unroll
                  for (int r = 0; r < 4; ++r) { const int rl = r0 + r, row = MP + rl; const float v = acc[r] * pg8::rstd_of(ssp, row); const int col = 32 * cg + 16 * j + fr;
                      if (col < DM) gb[(size_t)row * DM + col] = f2bf_rne(gelu_tanh_(v));
                      else { ub[(size_t)row * DM + col - DM] = f2bf_rne(v); const int tt = rl & 15; if (tt >= 13) o[O_SLC + ((size_t)(rl >> 4) * 3 + (tt - 13)) * DM + col - DM] = v; } } }); } }
    SEAM(10);

    if (IN(11)) {
        const float* cw = a.in[19]; const float* cbias = a.in[20];
        for (int it = gt; it < (MV / 16) * 256; it += GT) { const int cgp = it & 255, run = it >> 8, row0 = run * 16, ch = cgp * 8;
            float w0[8], w1[8], w2[8], k0[8], k1[8], k2[8], k3[8], cb8[8];
#pragma unroll
            for (int j = 0; j < 8; ++j) { k0[j] = cw[ch + j]; k1[j] = cw[DM + ch + j]; k2[j] = cw[2 * DM + ch + j]; k3[j] = cw[3 * DM + ch + j]; cb8[j] = cbias[ch + j]; w0[j] = 0.f; w1[j] = 0.f; w2[j] = 0.f; }
            if (row0 >= MP) { const float* st = a.in[9] + (size_t)((row0 - MP) >> 4) * 3 * DM + ch;
#pragma unroll
                for (int j = 0; j < 8; ++j) { w0[j] = st[j]; w1[j] = st[DM + j]; w2[j] = st[2 * DM + j]; }
            } else if ((row0 & (SEQ - 1)) != 0) {
                const u32x4 a0 = *(const u32x4*)(Ub + (size_t)(row0 - 3) * DM + ch), a1 = *(const u32x4*)(Ub + (size_t)(row0 - 2) * DM + ch), a2 = *(const u32x4*)(Ub + (size_t)(row0 - 1) * DM + ch);
#pragma unroll
                for (int j = 0; j < 4; ++j) { w0[2 * j] = bflo(a0[j]); w0[2 * j + 1] = bfhi(a0[j]); w1[2 * j] = bflo(a1[j]); w1[2 * j + 1] = bfhi(a1[j]); w2[2 * j] = bflo(a2[j]); w2[2 * j + 1] = bfhi(a2[j]); }
            }
#pragma unroll 8
            for (int t = 0; t < 16; ++t) { const u32x4 cu = *(const u32x4*)(Ub + (size_t)(row0 + t) * DM + ch); float c8[8], o8[8];
#pragma unroll
                for (int j = 0; j < 4; ++j) { c8[2 * j] = bflo(cu[j]); c8[2 * j + 1] = bfhi(cu[j]); }
#pragma unroll
                for (int j = 0; j < 8; ++j) { o8[j] = cb8[j] + w0[j] * k0[j] + w1[j] * k1[j] + w2[j] * k2[j] + c8[j] * k3[j]; w0[j] = w1[j]; w1[j] = w2[j]; w2[j] = c8[j]; }
                u32x4 w; w.x = cvt_pk_bf16(o8[0], o8[1]); w.y = cvt_pk_bf16(o8[2], o8[3]); w.z = cvt_pk_bf16(o8[4], o8[5]); w.w = cvt_pk_bf16(o8[6], o8[7]);
                *(u32x4*)(UCb + (size_t)(row0 + t) * DM + ch) = w; }
        }
    }
    SEAM(11);

    if (IN(12)) { pg8::Gemm g{UCb, WGATE, DM, 256, 256, 256, NOB, 0, 128}; pg8::StaticOrder S; S.init(NTM, 16, G, bx);
        pg8::EpiGates E{UCb, a.in[22], a.in[24], SPL, LAb, BBb}; pg8::gemm_phase(lds3, g, S, E); }
    SEAM(12);

#define LOAD8(dst, p) do { const u32x4 w_ = *(const u32x4*)(p); _Pragma("unroll") for (int j_ = 0; j_ < 4; ++j_) { dst[2 * j_] = bflo(w_[j_]); dst[2 * j_ + 1] = bfhi(w_[j_]); } } while (0)
    if (IN(13)) {
        for (int it = gt; it < NB * 64 * 256; it += GT) { const int cgp = it & 255, c = (it >> 8) & 63, b = it >> 14, ch = cgp * 8; const size_t row0 = (size_t)b * SEQ + c * 64;
            float As[8], h[8];
#pragma unroll
            for (int j = 0; j < 8; ++j) { As[j] = 0.f; h[j] = 0.f; }
#pragma unroll 8
            for (int t = 0; t < 64; ++t) { float la[8], bb[8]; LOAD8(la, LAb + (row0 + t) * DM + ch); LOAD8(bb, BBb + (row0 + t) * DM + ch);
#pragma unroll
                for (int j = 0; j < 8; ++j) { h[j] = lru_step(h[j], la[j], bb[j]); As[j] += la[j]; } }
            float* pa = CA + ((size_t)(b * 64 + c)) * DM + ch; float* pb = CBv + ((size_t)(b * 64 + c)) * DM + ch;
#pragma unroll
            for (int j = 0; j < 8; ++j) { pa[j] = __expf(As[j]); pb[j] = h[j]; }
        }
        for (int it = gt; it < NB * 256; it += GT) { const int cgp = it & 255, b = it >> 8, ch = cgp * 8; const size_t row0 = (size_t)MP + b * DSQ;
            float h[8];
#pragma unroll
            for (int j = 0; j < 8; ++j) h[j] = a.in[8][(size_t)b * DM + ch + j];
            for (int t = 0; t < DSQ; ++t) { float la[8], bb[8], gg[8], y[8]; LOAD8(la, LAb + (row0 + t) * DM + ch); LOAD8(bb, BBb + (row0 + t) * DM + ch); LOAD8(gg, Gb + (row0 + t) * DM + ch);
#pragma unroll
                for (int j = 0; j < 8; ++j) { h[j] = lru_step(h[j], la[j], bb[j]); y[j] = h[j] * gg[j]; }
                u32x4 w; w.x = cvt_pk_bf16(y[0], y[1]); w.y = cvt_pk_bf16(y[2], y[3]); w.z = cvt_pk_bf16(y[4], y[5]); w.w = cvt_pk_bf16(y[6], y[7]);
                *(u32x4*)(Gb + (row0 + t) * DM + ch) = w; }
#pragma unroll
            for (int j = 0; j < 8; ++j) out[O_SLH + (size_t)b * DM + ch + j] = h[j];
        }
    }
    SEAM(13);
    if (IN(14)) {
        for (int it = gt; it < NB * DM; it += GT) { const int b = it >> 11, ch = it & (DM - 1); float h = 0.f;
            for (int c0 = 0; c0 < 64; c0 += 16) { float A[16], B[16];
#pragma unroll
                for (int k = 0; k < 16; ++k) { const size_t o = ((size_t)(b * 64 + c0 + k)) * DM + ch; A[k] = CA[o]; B[k] = CBv[o]; }
#pragma unroll
                for (int k = 0; k < 16; ++k) { const size_t o = ((size_t)(b * 64 + c0 + k)) * DM + ch; CBv[o] = h; h = A[k] * h + B[k]; } } }
    }
    SEAM(14);
    if (IN(15)) {
        for (int it = gt; it < NB * 64 * 256; it += GT) { const int cgp = it & 255, c = (it >> 8) & 63, b = it >> 14, ch = cgp * 8; const size_t row0 = (size_t)b * SEQ + c * 64;
            float h[8]; const float* pb = CBv + ((size_t)(b * 64 + c)) * DM + ch;
#pragma unroll
            for (int j = 0; j < 8; ++j) h[j] = pb[j];
#pragma unroll 8
            for (int t = 0; t < 64; ++t) { float la[8], bb[8], gg[8], y[8]; LOAD8(la, LAb + (row0 + t) * DM + ch); LOAD8(bb, BBb + (row0 + t) * DM + ch); LOAD8(gg, Gb + (row0 + t) * DM + ch);
#pragma unroll
                for (int j = 0; j < 8; ++j) { h[j] = lru_step(h[j], la[j], bb[j]); y[j] = h[j] * gg[j]; }
                u32x4 w; w.x = cvt_pk_bf16(y[0], y[1]); w.y = cvt_pk_bf16(y[2], y[3]); w.z = cvt_pk_bf16(y[4], y[5]); w.w = cvt_pk_bf16(y[6], y[7]);
                *(u32x4*)(Gb + (row0 + t) * DM + ch) = w; }
            if (c == 63) {
#pragma unroll
                for (int j = 0; j < 8; ++j) out[O_PLH + (size_t)b * DM + ch + j] = h[j]; }
        }
    }
    SEAM(15);
#undef LOAD8

    if (IN(16)) { pg8::Gemm g{Gb, WLOUT, DM, DM, DM, 0, NOB, 0, 128}; pg8::StaticOrder S; S.init(128, 8, G, bx);
        pg8::EpiRes E{XB, SS + 4 * MR}; pg8::gemm_phase(lds3, g, S, E);
        sgemm_res((char*)lds, Gb + (size_t)MP * DM, DM, DM, vcu, G, WLOUT, DM, XB, SS + 4 * MR); }
    SEAM(16);

    XATTN_FFN(1, 17, 4, 5, 6);

    if (IN(22)) {
        const float* ss6 = SS + 6 * MR;
        for (int r0 = gw; r0 < MV; r0 += 2 * NGW) {
            u32x2 w[2][8];
#pragma unroll
            for (int q = 0; q < 2; ++q) { const int r = (r0 + q * NGW < MV) ? r0 + q * NGW : r0; const u32x2* xr = (const u32x2*)(XB + (size_t)r * DM) + lane;
#pragma unroll
                for (int j = 0; j < 8; ++j) w[q][j] = xr[64 * j]; }
#pragma unroll
            for (int q = 0; q < 2; ++q) { const int r = r0 + q * NGW; if (r < MV) { const float rs = __builtin_amdgcn_rsqf(ss6[r] * (1.f / DM) + EPS);
                f32x4* yr = (f32x4*)(out + (size_t)r * DM) + lane; const f32x4* gr = (const f32x4*)a.in[14] + lane;
#pragma unroll
                for (int j = 0; j < 8; ++j) { const f32x4 g4 = gr[64 * j];
                    f32x4 y; y[0] = bflo(w[q][j].x) * rs * g4[0]; y[1] = bfhi(w[q][j].x) * rs * g4[1]; y[2] = bflo(w[q][j].y) * rs * g4[2]; y[3] = bfhi(w[q][j].y) * rs * g4[3]; __builtin_nontemporal_store(y, &yr[64 * j]); } } }
        }
    }
#undef IN
#undef SEAM
#undef XATTN_FFN
}

constexpr int N_PHASES = 23;

extern "C" void kernel_launch(void* const* d_in, const int* in_sizes, int n_in, void* d_out, int out_size, void* d_ws, size_t ws_size, hipStream_t stream) {
    static int grid = 0;
    if (grid == 0) {
        if (n_in != 32 || (size_t)out_size != O_END || ws_size < WS_END) { fprintf(stderr, "kernel_launch: unexpected shapes: n_in %d out %d (want %zu) ws %zu (want >= %zu)\n", n_in, out_size, (size_t)O_END, ws_size, (size_t)WS_END); grid = -1; return; }
        int dev = 0, cus = 0, per_cu = 0;
        if (hipGetDevice(&dev) != hipSuccess || hipDeviceGetAttribute(&cus, hipDeviceAttributeMultiprocessorCount, dev) != hipSuccess) { grid = -1; return; }
        if (hipFuncSetAttribute((const void*)mk_fwd, hipFuncAttributeMaxDynamicSharedMemorySize, LDS_BYTES) != hipSuccess) { fprintf(stderr, "kernel_launch: hipFuncSetAttribute failed\n"); grid = -1; return; }
        if (hipOccupancyMaxActiveBlocksPerMultiprocessor(&per_cu, (const void*)mk_fwd, 512, LDS_BYTES) != hipSuccess || per_cu < 1) { fprintf(stderr, "kernel_launch: occupancy query gave %d\n", per_cu); per_cu = 1; }
        (void)hipGetLastError();
        grid = cus * 1;
    }
    if (grid < 0) return;
    Args a{};
    for (int i = 0; i < 32; ++i) a.in[i] = (const float*)d_in[i];
    a.out = (float*)d_out; a.ws = (unsigned char*)d_ws;
    static bool per_phase = (MK_PER_PHASE != 0);
    if (!per_phase) {
        (void)hipMemsetAsync((unsigned char*)d_ws + WS_BAR, 0, 16384, stream);
        a.ph_lo = 0; a.ph_hi = N_PHASES;
        void* args[] = {&a};
        hipError_t e = hipLaunchCooperativeKernel((const void*)mk_fwd, dim3(grid), dim3(512), args, LDS_BYTES, stream);
        if (e == hipSuccess) return;
        fprintf(stderr, "kernel_launch: cooperative launch failed: %s (grid %d); falling back to one launch per phase\n", hipGetErrorString(e), grid);
        (void)hipGetLastError(); per_phase = true;
    }
    for (int p = 0; p < N_PHASES; ++p) { a.ph_lo = p; a.ph_hi = p + 1; hipLaunchKernelGGL(mk_fwd, dim3(grid), dim3(512), LDS_BYTES, stream, a); }
}
```
